# Optimizing an MI355X kernel written in HIP

```python
import jax, jax.numpy as jnp
from jax import lax
import numpy as np

D_MODEL = 1024
BATCH = 2
SEQ = 8192
DEPTH = 2

GRID_W = 64
CTX_LEN = 256
HEAD_DIM = 128
N_Q_HEADS = 4
N_KV_HEADS = 2
ATTN_WIDTH = N_Q_HEADS * HEAD_DIM
KV_WIDTH = N_KV_HEADS * HEAD_DIM
CONV_WIDTH = D_MODEL - ATTN_WIDTH
SHORT_CONV_K = 3
IN_PROJ_WIDTH = ATTN_WIDTH + 2 * KV_WIDTH + 3 * CONV_WIDTH
PROJ_SPLITS = (ATTN_WIDTH,
               ATTN_WIDTH + KV_WIDTH,
               ATTN_WIDTH + 2 * KV_WIDTH,
               ATTN_WIDTH + 2 * KV_WIDTH + CONV_WIDTH,
               ATTN_WIDTH + 2 * KV_WIDTH + 2 * CONV_WIDTH)
Q_BLOCK = 128
ROPE_THETA = 10000.0
POOL_WINDOWS = (2, 4, 8, 16)
N_POOL_GROUPS = len(POOL_WINDOWS)
POOL_GROUP = D_MODEL // N_POOL_GROUPS
D_FF = 2816
FFN_CONV_K = 3
N_MOD = 6
EPS = 1e-6
N_EVEN = (DEPTH + 1) // 2
N_ODD = DEPTH // 2

kernel_name = "hybrid_gqa_shortconv_pool_convglu_dit"


def rms_norm(x, gain):
    xf = x.astype(jnp.float32)
    y = xf * lax.rsqrt(jnp.mean(xf * xf, axis=-1, keepdims=True) + EPS)
    return (y * gain.astype(jnp.float32)).astype(x.dtype)


def modulate(h, shift, scale):
    return h * (1.0 + scale) + shift


def dwconv_centred(h, w):
    k = w.shape[0]
    p = k // 2
    n = h.shape[1]
    hp = jnp.pad(h, ((0, 0), (p, p), (0, 0)))
    return sum(hp[:, j:j + n] * w[j] for j in range(k))


def axial_rope_tables(rows):
    row_ids = jnp.repeat(jnp.arange(rows), GRID_W).astype(jnp.float32)
    col_ids = jnp.tile(jnp.arange(GRID_W), rows).astype(jnp.float32)
    axis_dim = HEAD_DIM // 2
    inv_freq = jnp.power(ROPE_THETA, -jnp.arange(0, axis_dim, 2, dtype=jnp.float32) / axis_dim)
    ang = jnp.stack([row_ids[:, None] * inv_freq, col_ids[:, None] * inv_freq], axis=1)
    return jnp.cos(ang), jnp.sin(ang)


def apply_axial_rope(x, cos, sin):
    b, n, h, d = x.shape
    xr = x.reshape(b, n, h, 2, 2, d // 4)
    x1, x2 = xr[..., 0, :], xr[..., 1, :]
    c = cos[None, :, None].astype(x.dtype)
    s = sin[None, :, None].astype(x.dtype)
    out = jnp.stack([x1 * c - x2 * s, x2 * c + x1 * s], axis=-2)
    return out.reshape(b, n, h, d)


def gqa_softmax(qg, k, v):
    scores = jnp.einsum('bqkgd,btkd->bkgqt', qg, k).astype(jnp.float32) * (HEAD_DIM ** -0.5)
    p = jax.nn.softmax(scores, axis=-1).astype(v.dtype)
    return jnp.einsum('bkgqt,btkd->bqkgd', p, v)


def latent_attention(q, k_lat, v_lat, k_ctx, v_ctx):
    b, n, hq, hd = q.shape
    g = hq // N_KV_HEADS
    k_all = jnp.concatenate([k_ctx, k_lat], axis=1)
    v_all = jnp.concatenate([v_ctx, v_lat], axis=1)
    nblk = n // Q_BLOCK
    qb = q.reshape(b, nblk, Q_BLOCK, N_KV_HEADS, g, hd).transpose(1, 0, 2, 3, 4, 5)
    out = lax.map(lambda qblk: gqa_softmax(qblk, k_all, v_all), qb)
    return out.transpose(1, 0, 2, 3, 4, 5).reshape(b, n, hq * hd)


def context_attention(q, k, v):
    b, n, hq, hd = q.shape
    qg = q.reshape(b, n, N_KV_HEADS, hq // N_KV_HEADS, hd)
    return gqa_softmax(qg, k, v).reshape(b, n, hq * hd)


def split_projection(p, q_gain, k_gain):
    b, n, _ = p.shape
    q, k, v, gate_b, gate_c, x_in = jnp.split(p, PROJ_SPLITS, axis=-1)
    q = rms_norm(q.reshape(b, n, N_Q_HEADS, HEAD_DIM), q_gain)
    k = rms_norm(k.reshape(b, n, N_KV_HEADS, HEAD_DIM), k_gain)
    v = v.reshape(b, n, N_KV_HEADS, HEAD_DIM)
    return q, k, v, gate_b, gate_c, x_in


def even_mixer(a_lat, a_ctx, cos, sin, w_in, q_gain, k_gain, conv_w, w_out, with_ctx_out):
    b, lc, _ = a_ctx.shape
    if with_ctx_out:
        cq, ck, cv, cgb, cgc, cxin = split_projection(a_ctx @ w_in, q_gain, k_gain)
    else:
        ckv = a_ctx @ w_in[:, ATTN_WIDTH:ATTN_WIDTH + 2 * KV_WIDTH]
        ck, cv = jnp.split(ckv, 2, axis=-1)
        ck = rms_norm(ck.reshape(b, lc, N_KV_HEADS, HEAD_DIM), k_gain)
        cv = cv.reshape(b, lc, N_KV_HEADS, HEAD_DIM)
    q, k, v, gate_b, gate_c, x_in = split_projection(a_lat @ w_in, q_gain, k_gain)
    q = apply_axial_rope(q, cos, sin)
    k = apply_axial_rope(k, cos, sin)
    attn = latent_attention(q, k, v, ck, cv)
    conv = gate_b * dwconv_centred(gate_c * x_in, conv_w)
    y_lat = jnp.concatenate([attn, conv], axis=-1) @ w_out
    y_ctx = None
    if with_ctx_out:
        c_attn = context_attention(cq, ck, cv)
        c_conv = cgb * dwconv_centred(cgc * cxin, conv_w)
        y_ctx = jnp.concatenate([c_attn, c_conv], axis=-1) @ w_out
    return y_lat, y_ctx


def pool_mixer(h, pool_w, pool_scale):
    b, n, d = h.shape
    hf = h.astype(jnp.float32)
    cs = jnp.pad(jnp.cumsum(hf, axis=1), ((0, 0), (1, 0), (0, 0)))
    t = jnp.arange(n)
    groups = []
    for gi, w in enumerate(POOL_WINDOWS):
        lo = jnp.clip(t - w // 2, 0, n)
        hi = jnp.clip(t + w - w // 2, 0, n)
        sl = slice(gi * POOL_GROUP, (gi + 1) * POOL_GROUP)
        csg = cs[:, :, sl]
        mean = (csg[:, hi] - csg[:, lo]) / (hi - lo).astype(jnp.float32)[None, :, None]
        groups.append(mean - hf[:, :, sl])
    pooled = jnp.stack(groups, axis=2).astype(h.dtype)
    mixed = jnp.einsum('bngc,gce->bnge', pooled, pool_w).reshape(b, n, d)
    return mixed * pool_scale


def conv_glu(h, w_up, conv_w, conv_b, w_down):
    gate, val = jnp.split(h @ w_up, 2, axis=-1)
    gate = dwconv_centred(gate, conv_w) + conv_b
    return (jax.nn.silu(gate) * val) @ w_down


def setup_inputs(seed: int = 0) -> dict:
    key = jax.random.key(seed)
    ks = jax.random.split(key, 24)
    f32 = jnp.float32
    nrm = lambda k, shape, s: jax.random.normal(k, shape, f32) * s
    d = D_MODEL
    return {
        "x": nrm(ks[0], (BATCH, SEQ, d), 1.0),
        "c": nrm(ks[1], (BATCH, d), 1.0),
        "ctx": nrm(ks[2], (BATCH, CTX_LEN, d), 1.0),
        "c_ctx": nrm(ks[3], (d,), 1.0),
        "ada_w": nrm(ks[4], (DEPTH, d, N_MOD * d), 0.5 * d ** -0.5),
        "ada_b": nrm(ks[5], (DEPTH, N_MOD * d), 0.02),
        "mix_norm": 1.0 + nrm(ks[6], (DEPTH, d), 0.02),
        "ffn_norm": 1.0 + nrm(ks[7], (DEPTH, d), 0.02),
        "even_w_in": nrm(ks[8], (N_EVEN, d, IN_PROJ_WIDTH), d ** -0.5),
        "even_q_gain": 1.0 + nrm(ks[9], (N_EVEN, HEAD_DIM), 0.02),
        "even_k_gain": 1.0 + nrm(ks[10], (N_EVEN, HEAD_DIM), 0.02),
        "even_conv_w": nrm(ks[11], (N_EVEN, SHORT_CONV_K, CONV_WIDTH), SHORT_CONV_K ** -0.5),
        "even_w_out": nrm(ks[12], (N_EVEN, ATTN_WIDTH + CONV_WIDTH, d), (ATTN_WIDTH + CONV_WIDTH) ** -0.5),
        "odd_pool_w": nrm(ks[13], (N_ODD, N_POOL_GROUPS, POOL_GROUP, POOL_GROUP), POOL_GROUP ** -0.5),
        "odd_pool_scale": 1.0 + nrm(ks[14], (N_ODD, d), 0.02),
        "ffn_w_up": nrm(ks[15], (DEPTH, d, 2 * D_FF), d ** -0.5),
        "ffn_conv_w": nrm(ks[16], (DEPTH, FFN_CONV_K, D_FF), FFN_CONV_K ** -0.5),
        "ffn_conv_b": nrm(ks[17], (DEPTH, D_FF), 0.02),
        "ffn_w_down": nrm(ks[18], (DEPTH, D_FF, d), D_FF ** -0.5),
    }


def reference(x, c, ctx, c_ctx, ada_w, ada_b, mix_norm, ffn_norm, even_w_in, even_q_gain, even_k_gain,
              even_conv_w, even_w_out, odd_pool_w, odd_pool_scale, ffn_w_up, ffn_conv_w, ffn_conv_b, ffn_w_down):
    b, n, d = x.shape
    rows = n // GRID_W
    cos, sin = axial_rope_tables(rows)
    silu_c = jax.nn.silu(c)
    silu_cc = jax.nn.silu(c_ctx)
    h_ctx = ctx
    for l in range(DEPTH):
        ctx_later = any(j % 2 == 0 for j in range(l + 1, DEPTH))
        need_ctx = (l % 2 == 0) or ctx_later
        mod_lat = (silu_c @ ada_w[l] + ada_b[l])[:, None, :]
        sh1, sc1, g1, sh2, sc2, g2 = jnp.split(mod_lat, N_MOD, axis=-1)
        a_lat = modulate(rms_norm(x, mix_norm[l]), sh1, sc1)
        if need_ctx:
            mod_ctx = (silu_cc @ ada_w[l] + ada_b[l])[None, None, :]
            csh1, csc1, cg1, csh2, csc2, cg2 = jnp.split(mod_ctx, N_MOD, axis=-1)
            a_ctx = modulate(rms_norm(h_ctx, mix_norm[l]), csh1, csc1)
        if l % 2 == 0:
            e = l // 2
            y_lat, y_ctx = even_mixer(a_lat, a_ctx, cos, sin, even_w_in[e], even_q_gain[e], even_k_gain[e],
                                      even_conv_w[e], even_w_out[e], ctx_later)
        else:
            o = l // 2
            y_lat = pool_mixer(a_lat, odd_pool_w[o], odd_pool_scale[o])
            y_ctx = pool_mixer(a_ctx, odd_pool_w[o], odd_pool_scale[o]) if ctx_later else None
        x = x + g1 * y_lat
        f_lat = modulate(rms_norm(x, ffn_norm[l]), sh2, sc2)
        x = x + g2 * conv_glu(f_lat, ffn_w_up[l], ffn_conv_w[l], ffn_conv_b[l], ffn_w_down[l])
        if ctx_later:
            h_ctx = h_ctx + cg1 * y_ctx
            f_ctx = modulate(rms_norm(h_ctx, ffn_norm[l]), csh2, csc2)
            h_ctx = h_ctx + cg2 * conv_glu(f_ctx, ffn_w_up[l], ffn_conv_w[l], ffn_conv_b[l], ffn_w_down[l])
    return x
```

```cpp
#include <hip/hip_runtime.h>
#include <hip/hip_bf16.h>
#include <cstdio>
#include <cstdint>
#include <type_traits>

#ifndef MK_N_LAUNCHES
#define MK_N_LAUNCHES 1
#endif

#ifndef DBG_MAXPH
#define DBG_MAXPH 13
#ifndef PROBE_FLAGS
#define PROBE_FLAGS 0
#endif
#endif
#define LAS __attribute__((address_space(3)))
#define GAS __attribute__((address_space(1)))
typedef unsigned short bf16_t;
typedef short bf16x8 __attribute__((ext_vector_type(8)));
typedef float f32x4 __attribute__((ext_vector_type(4)));
typedef float f32x2 __attribute__((ext_vector_type(2)));
typedef unsigned u32x4 __attribute__((ext_vector_type(4)));
typedef unsigned u32x2 __attribute__((ext_vector_type(2)));
typedef __bf16 bf16x2_t __attribute__((ext_vector_type(2)));

constexpr int DM = 1024, SEQ = 8192, NB = 2, MROWS = NB * SEQ, CTXL = 256, MCTX = NB * CTXL, MALL = MROWS + MCTX;
constexpr int NIN = 2560, DFF = 2816, NUP = 2 * DFF, SKV = CTXL + SEQ;
constexpr int NMOD = 6 * DM;
constexpr float EPS = 1e-6f;
constexpr int NTHREADS = 512, NWAVES = 8;

constexpr size_t al256(size_t x) { return (x + 255) & ~(size_t)255; }
constexpr size_t WS_CTL = 0, CTL_BYTES = 1u << 20;
constexpr size_t WS_MODF = CTL_BYTES;
constexpr size_t WS_TAB = WS_MODF + al256((size_t)2 * 3 * NMOD * 4);
constexpr size_t WS_BIN = WS_TAB + al256((size_t)192 * 32 * 8);
constexpr size_t WS_BUP = WS_BIN + al256((size_t)3 * NIN * 4);
constexpr size_t WS_GP = WS_BUP + al256((size_t)4 * NUP * 4);
constexpr size_t WS_RSTD0 = WS_GP + al256(256 * 4);
constexpr size_t WS_SSQ = WS_RSTD0 + al256((size_t)MALL * 4);
constexpr size_t SSQ_BYTES = al256((size_t)MROWS * 16 * 4);
constexpr size_t WS_HALO = WS_SSQ + 3 * SSQ_BYTES;
constexpr size_t WS_WIN = WS_HALO + al256((size_t)64 * 22 * 6 * 128 * 4);
constexpr size_t WS_WOUT = WS_WIN + al256((size_t)3 * NIN * DM * 2);
constexpr size_t WS_WPOOL = WS_WOUT + al256((size_t)DM * DM * 2);
constexpr size_t WS_WUP = WS_WPOOL + al256((size_t)4 * 256 * 256 * 2);
constexpr size_t WS_WDN = WS_WUP + al256((size_t)4 * NUP * DM * 2);
constexpr size_t WS_XB = WS_WDN + al256((size_t)2 * DM * DFF * 2);
constexpr size_t WS_R2 = WS_XB + al256((size_t)MALL * DM * 2);
constexpr size_t WS_Q = WS_R2;
constexpr size_t WS_KA = WS_Q + al256((size_t)MROWS * 512 * 2);
constexpr size_t WS_VA = WS_KA + al256((size_t)NB * SKV * 256 * 2);
constexpr size_t WS_BU = WS_VA + al256((size_t)NB * SKV * 256 * 2);
constexpr size_t WS_CC = WS_BU + al256((size_t)MROWS * DM * 2);
constexpr size_t WS_END = WS_CC + al256((size_t)MROWS * DM * 2);
constexpr size_t WS_H = WS_R2;
constexpr size_t WS_PL = WS_R2;
static_assert(WS_H + (size_t)MROWS * DFF * 2 <= WS_END, "H overlay");
constexpr size_t WS_XE = WS_END;
constexpr size_t WS_TOP = WS_XE + (size_t)64 * 4 * 16 * 256 * 4;
static_assert(WS_TOP <= (size_t)256 * 1024 * 1024, "workspace");

constexpr int RING_BYTES = 131072;
constexpr int XCH_OFF = RING_BYTES;
constexpr int MISC_OFF = XCH_OFF + 16384;
constexpr int LDS_BYTES = MISC_OFF + 256;

__device__ __forceinline__ unsigned cvtpk(float lo, float hi) { f32x2 v = {lo, hi}; bf16x2_t b = __builtin_convertvector(v, bf16x2_t); return __builtin_bit_cast(unsigned, b); }
__device__ __forceinline__ void st16_wt(void* p, u32x4 w) { asm volatile("global_store_dwordx4 %0, %1, off sc1\n\ts_nop 1" :: "v"(p), "v"(w) : "memory"); }
__device__ __forceinline__ void st8_wt(void* p, u32x2 w) { asm volatile("global_store_dwordx2 %0, %1, off sc1\n\ts_nop 1" :: "v"(p), "v"(w) : "memory"); }
__device__ __forceinline__ float bflo(unsigned w) { return __uint_as_float(w << 16); }
__device__ __forceinline__ float bfhi(unsigned w) { return __uint_as_float(w & 0xffff0000u); }
__device__ __forceinline__ float silu_f(float x) { return x * __builtin_amdgcn_rcpf(1.0f + __builtin_amdgcn_exp2f(-1.4426950408889634f * x)); }
__device__ __forceinline__ float wave_sum(float v) {
#pragma unroll
    for (int o = 1; o < 64; o <<= 1) v += __shfl_xor(v, o);
    return v;
}
#define LDS_WAIT() asm volatile("s_waitcnt lgkmcnt(0)" ::: "memory")
#define VM_WAIT() asm volatile("s_waitcnt vmcnt(0)" ::: "memory")
#define RLX_AGENT __ATOMIC_RELAXED, __HIP_MEMORY_SCOPE_AGENT

__device__ __forceinline__ int map_in(int o) {
    if (o < 768) { const int base = o & ~127, d = o & 127, a = d >> 6, hf = (d >> 5) & 1, i = d & 31; return base + 2 * (a * 32 + i) + hf; }
    if (o < 1536) return o;
    const int s = (o >= 2048) ? 1 : 0, ch = o - (s ? 2048 : 1536); return 1536 + 256 * (ch >> 7) + 128 * s + (ch & 127);
}
__device__ __forceinline__ int map_up(int o) { const int s = (o >= DFF) ? 1 : 0, ch = o - s * DFF; return 256 * (ch >> 7) + 128 * s + (ch & 127); }

struct Args {
    const float *x, *c, *ctx, *c_ctx, *ada_w, *ada_b, *mix_norm, *ffn_norm, *w_in, *q_gain, *k_gain, *conv_w, *w_out, *pool_w, *pool_scale, *w_up, *fconv_w, *fconv_b, *w_down;
    float* out; unsigned char* ws; int ph_lo, ph_hi, grid, pad;
    int prog[16];
};
typedef const Args __attribute__((address_space(4))) KArgs;

namespace pg8 {
constexpr int BM = 256, BK = 64, HALF = 128, HTB = HALF * BK * 2, NXCD = 8, WGM = 8;
__host__ __device__ __forceinline__ int lds_byte(int r, int c) { const int st = (r >> 4) * 2 + (c >> 5), rr = r & 15, cc = c & 31, ob = rr * 64 + cc * 2; return st * 1024 + (ob ^ (((ob >> 9) & 1) << 5)); }
__host__ __device__ __forceinline__ void stage_rc(int b, int& R, int& C) { const int st = b / 1024, sb = b % 1024, swz = sb ^ (((sb >> 9) & 1) << 5); R = (st >> 1) * 16 + swz / 64; C = (st & 1) * 32 + (swz % 64) / 2; }
__host__ __device__ __forceinline__ int perm32(int rho) { const int n = rho >> 4, i = rho & 15; return 8 * (i >> 2) + 4 * n + (i & 3); }

struct Unit { int pm, pn; };
struct Gemm { const bf16_t* A; int lda; int acol; const bf16_t* Bt; int ldb; int K; size_t bbatch; };

struct StaticOrder {
    int nM, nN, nwg, G, c;
    __device__ void init(int M, int N, int G_, int c_) { nM = M / BM; nN = N / BM; nwg = nM * nN; G = G_; c = c_; }
    __device__ __forceinline__ void tile(int L, Unit& u) const {
        int wgid = L; { const int q = nwg / NXCD, r = nwg % NXCD, xcd = wgid % NXCD, off = wgid / NXCD; wgid = (xcd < r ? xcd * (q + 1) : r * (q + 1) + (xcd - r) * q) + off; }
        const int nig = WGM * nN, gid = wgid / nig, fm = gid * WGM, gsz = (nM - fm) < WGM ? (nM - fm) : WGM;
        u.pm = fm + ((wgid % nig) % gsz); u.pn = (wgid % nig) / gsz;
    }
    __device__ __forceinline__ bool next(int i, Unit& u) const { const long L = (long)i * G + c; if (L >= nwg) return false; tile((int)L, u); return true; }
};
struct InProjOrder {
    StaticOrder so;
    __device__ void init(int G_, int c_) { so.init(MROWS, NIN, G_, c_); }
    __device__ __forceinline__ bool next(int i, Unit& u) const {
        const long L = (long)i * so.G + so.c; if (L >= so.nwg + 4) return false;
        if (L < so.nwg) { so.tile((int)L, u); return true; }
        const int k = (int)L - so.nwg; u.pm = 64 + (k >> 1); u.pn = 2 + (k & 1); return true;
    }
};

template <class Epi, class Sched>
__device__ __forceinline__ void gemm_phase(LAS unsigned char* lds, LAS unsigned char* xlds, const Gemm g, const Sched& S, const Epi& E, const int tid, const int pmode = 0) {
    const int wid = __builtin_amdgcn_readfirstlane(tid >> 6), lane = tid & 63, wr = wid >> 2, wc = wid & 3, fr = lane & 15, fq = lane >> 4;
    const int K = g.K, nt = K / BK;
    unsigned voffA, voffB;
    { int R, C; stage_rc(tid * 16, R, C); const int Rb = Epi::PERM ? ((R & ~31) + perm32(R & 31)) : R;
      voffA = (unsigned)(R * g.lda + C) * 2u; voffB = (unsigned)(Rb * g.ldb + C) * 2u; }
    const size_t p2A = (size_t)64 * g.lda * 2, p2B = (size_t)64 * g.ldb * 2;
    const size_t kstep = (size_t)(BK * 2);
    const size_t hstepA = (size_t)HALF * g.lda * 2, hstepB = (size_t)HALF * g.ldb * 2;
    const unsigned ldsw = (unsigned)wid * 1024u;
    int aoff = lds_byte(wr * 64 + fr, fq * 8), boff = lds_byte(wc * 32 + fr, fq * 8) + 4 * HTB; asm volatile("" : "+v"(aoff), "+v"(boff));
#define PG8_SA(b, h) (((b) * 2 + (h)) * HTB)
#define PG8_SB(b, h) ((4 + (b) * 2 + (h)) * HTB)
#define PG8_STAGE_(bufoff, gbase, vo, p2) do { if (!(pmode & 2)) _Pragma("unroll") for (int _i = 0; _i < 2; ++_i) \
        __builtin_amdgcn_global_load_lds((const unsigned*)((const char*)(gbase) + (size_t)_i * (p2) + (vo)), (LAS unsigned*)(lds + (bufoff) + ldsw + _i * 8192), 16, 0, 0); } while (0)
#define PG8_STAGE(bufoff, gbase, which) PG8_STAGE_##which(bufoff, gbase)
#define PG8_STAGE_offA(bufoff, gbase) PG8_STAGE_(bufoff, gbase, voffA, p2A)
#define PG8_STAGE_offB(bufoff, gbase) PG8_STAGE_(bufoff, gbase, voffB, p2B)
#define PG8_LDA(dst, b, h) do { _Pragma("unroll") for (int m = 0; m < 4; ++m) _Pragma("unroll") for (int k = 0; k < 2; ++k) dst[m][k] = *(const LAS bf16x8*)(lds + aoff + (PG8_SA(b, h) + m * 2048 + k * 1024)); } while (0)
#define PG8_LDB(dst, b, h) do { _Pragma("unroll") for (int n = 0; n < 2; ++n) _Pragma("unroll") for (int k = 0; k < 2; ++k) dst[n][k] = *(const LAS bf16x8*)(lds + boff + (((b) * 2 + (h)) * HTB + n * 2048 + k * 1024)); } while (0)
#define PG8_MMA(ai, bj, At, Bt) do { __builtin_amdgcn_s_setprio(1); if (!(pmode & 1)) _Pragma("unroll") for (int m = 0; m < 4; ++m) _Pragma("unroll") for (int n = 0; n < 2; ++n) _Pragma("unroll") for (int k = 0; k < 2; ++k) \
        acc[ai][bj][m][n] = __builtin_amdgcn_mfma_f32_16x16x32_bf16(Bt[n][k], At[m][k], acc[ai][bj][m][n], 0, 0, 0); __builtin_amdgcn_s_setprio(0); } while (0)
#define PG8_WAIT_V(n) asm volatile("s_waitcnt vmcnt(" #n ")" ::: "memory")
#define PG8_WAIT_L(n) asm volatile("s_waitcnt lgkmcnt(" #n ")" ::: "memory")
#define PG8_BAR __builtin_amdgcn_s_barrier()
#define PG8_SCHED __builtin_amdgcn_sched_barrier(0)
#define PG8_UA(u) ((const char*)g.A + ((size_t)(u).pm * BM * g.lda + (size_t)(u).pn * g.acol) * 2)
#define PG8_UB(u) ((const char*)g.Bt + (size_t)(u).pn * BM * g.ldb * 2 + (size_t)((u).pm >= 64 ? 2 : ((u).pm >= 32 ? 1 : 0)) * g.bbatch)
    Unit cur, nxt; int ui = 0;
    if (!S.next(0, cur)) return;
    f32x4 acc[2][2][4][2];
#pragma unroll
    for (int a = 0; a < 2; ++a)
#pragma unroll
        for (int b = 0; b < 2; ++b)
#pragma unroll
            for (int m = 0; m < 4; ++m)
#pragma unroll
                for (int n = 0; n < 2; ++n) acc[a][b][m][n] = (f32x4){0.f, 0.f, 0.f, 0.f};
    bf16x8 At[4][2], B0[2][2], B1[2][2];
    const char* cA = PG8_UA(cur); const char* cB = PG8_UB(cur);
    PG8_STAGE(PG8_SB(0, 0), cB, offB); PG8_STAGE(PG8_SB(0, 1), cB + hstepB, offB); PG8_STAGE(PG8_SA(0, 0), cA, offA); PG8_STAGE(PG8_SA(0, 1), cA + hstepA, offA);
    if (wr == 1) PG8_BAR;
    PG8_WAIT_V(2); PG8_BAR;
    PG8_STAGE(PG8_SB(1, 0), cB + kstep, offB); PG8_STAGE(PG8_SA(1, 0), cA + kstep, offA); PG8_STAGE(PG8_SB(1, 1), cB + hstepB + kstep, offB);
    PG8_WAIT_V(6); PG8_BAR;
    for (;;) {
        const bool has_next = S.next(ui + 1, nxt);
        const char* nA = has_next ? PG8_UA(nxt) : cA; const char* nB = has_next ? PG8_UB(nxt) : cB;
        for (int t = 0; t < nt; t += 2) {
            const bool last = (t == nt - 2);
            const char* a1 = cA + (size_t)(t + 1) * kstep;
            const char* a2 = last ? nA : cA + (size_t)(t + 2) * kstep; const char* b2 = last ? nB : cB + (size_t)(t + 2) * kstep;
            const char* a3 = a2 + kstep; const char* b3 = b2 + kstep;
            PG8_LDB(B0, 0, 0); PG8_LDB(B1, 0, 1); PG8_SCHED; PG8_LDA(At, 0, 0); PG8_STAGE(PG8_SA(1, 1), a1 + hstepA, offA);
            PG8_WAIT_V(8); PG8_WAIT_L(0); PG8_BAR; PG8_MMA(0, 0, At, B0); PG8_MMA(0, 1, At, B1); PG8_BAR; PG8_SCHED;
            PG8_LDA(At, 0, 1); PG8_STAGE(PG8_SB(0, 0), b2, offB); PG8_STAGE(PG8_SB(0, 1), b2 + hstepB, offB); PG8_STAGE(PG8_SA(0, 0), a2, offA);
            PG8_WAIT_V(8); PG8_WAIT_L(0); PG8_BAR; PG8_MMA(1, 0, At, B0); PG8_MMA(1, 1, At, B1); PG8_BAR; PG8_SCHED;
            PG8_LDB(B0, 1, 0); PG8_LDB(B1, 1, 1); PG8_SCHED; PG8_LDA(At, 1, 0); PG8_STAGE(PG8_SA(0, 1), a2 + hstepA, offA);
            PG8_WAIT_V(8); PG8_WAIT_L(0); PG8_BAR; PG8_MMA(0, 0, At, B0); PG8_MMA(0, 1, At, B1); PG8_BAR; PG8_SCHED;
            PG8_LDA(At, 1, 1); PG8_STAGE(PG8_SB(1, 0), b3, offB); PG8_STAGE(PG8_SB(1, 1), b3 + hstepB, offB); PG8_STAGE(PG8_SA(1, 0), a3, offA);
            PG8_WAIT_V(8); PG8_WAIT_L(0); PG8_BAR; PG8_MMA(1, 0, At, B0); PG8_MMA(1, 1, At, B1); PG8_BAR; PG8_SCHED;
        }
        if (wr == 0) PG8_BAR;
        E(acc, cur, wr, wc, fr, fq, xlds, wid, lane);
        if (!has_next) break;
#pragma unroll
        for (int a = 0; a < 2; ++a)
#pragma unroll
            for (int b = 0; b < 2; ++b)
#pragma unroll
                for (int m = 0; m < 4; ++m)
#pragma unroll
                    for (int n = 0; n < 2; ++n) acc[a][b][m][n] = (f32x4){0.f, 0.f, 0.f, 0.f};
        cur = nxt; cA = nA; cB = nB; ++ui;
        if (wr == 1) PG8_BAR;
    }
    PG8_WAIT_V(0);
    PG8_BAR;
#undef PG8_SA
#undef PG8_SB
#undef PG8_STAGE
#undef PG8_STAGE_
#undef PG8_STAGE_offA
#undef PG8_STAGE_offB
#undef PG8_LDA
#undef PG8_LDB
#undef PG8_MMA
#undef PG8_UA
#undef PG8_UB
}
#define EPI_BAR() do { asm volatile("s_waitcnt lgkmcnt(0)" ::: "memory"); __builtin_amdgcn_s_barrier(); asm volatile("" ::: "memory"); } while (0)

struct EpiInProj {
    static constexpr bool PERM = true;
    unsigned char* wsb;
    __device__ __forceinline__ void operator()(f32x4 (&acc)[2][2][4][2], const Unit& u, int wr_, int wc_, int fr_, int fq_, LAS unsigned char* xlds, int wid, int lane) const {
        int wr = wr_, wc = wc_; asm volatile("" : "+s"(wr), "+s"(wc));
        int ln_; asm volatile("v_mbcnt_lo_u32_b32 %0, -1, 0\n\tv_mbcnt_hi_u32_b32 %0, -1, %0" : "=v"(ln_));
        const int fr = ln_ & 15, fq = ln_ >> 4; (void)fr_; (void)fq_;
        GAS unsigned char* ws = (GAS unsigned char*)wsb; asm volatile("" : "+s"(ws));
        const float* rstd0 = (const float*)(ws + WS_RSTD0); const float* bias = (const float*)(ws + WS_BIN); const float* gperm = (const float*)(ws + WS_GP); const f32x2* tab = (const f32x2*)(ws + WS_TAB);
        bf16_t* Q = (bf16_t*)(ws + WS_Q); bf16_t* KA = (bf16_t*)(ws + WS_KA); bf16_t* VA = (bf16_t*)(ws + WS_VA); bf16_t* BU = (bf16_t*)(ws + WS_BU);
        const int pm = u.pm, pn = u.pn;
        const int vec = pm < 32 ? 0 : (pm < 64 ? 1 : 2);
        const int c8 = wc * 32 + fq * 8;
        const float* bp = bias + vec * NIN + pn * 256 + c8;
        {
            f32x4 bv[2][2];
#pragma unroll
            for (int bj = 0; bj < 2; ++bj)
#pragma unroll
                for (int n = 0; n < 2; ++n) bv[bj][n] = *(const f32x4*)(bp + bj * 128 + 4 * n);
            float rs[2][4];
#pragma unroll
            for (int ai = 0; ai < 2; ++ai)
#pragma unroll
                for (int m = 0; m < 4; ++m) rs[ai][m] = rstd0[pm * 256 + ai * 128 + wr * 64 + m * 16 + fr];
#pragma unroll
            for (int ai = 0; ai < 2; ++ai) {
#pragma unroll
                for (int m = 0; m < 4; ++m)
#pragma unroll
                    for (int bj = 0; bj < 2; ++bj)
#pragma unroll
                        for (int n = 0; n < 2; ++n) acc[ai][bj][m][n] = acc[ai][bj][m][n] * rs[ai][m] + bv[bj][n];
            }
        }
        if (pn <= 2) {
            LAS float* X = (LAS float*)xlds;
#pragma unroll
            for (int ai = 0; ai < 2; ++ai)
#pragma unroll
                for (int m = 0; m < 4; ++m)
#pragma unroll
                    for (int bj = 0; bj < 2; ++bj) { const f32x4 a = acc[ai][bj][m][0], b = acc[ai][bj][m][1];
                        float s = (a[0] * a[0] + a[1] * a[1]) + (a[2] * a[2] + a[3] * a[3]) + (b[0] * b[0] + b[1] * b[1]) + (b[2] * b[2] + b[3] * b[3]);
                        s += __shfl_xor(s, 16); s += __shfl_xor(s, 32);
                        if (fq == 0) X[(ai * 128 + wr * 64 + m * 16 + fr) * 8 + bj * 4 + wc] = s; }
            EPI_BAR();
            const float* gp = gperm + (pn == 2 ? 128 : 0) + c8;
            const f32x4 g0 = *(const f32x4*)(gp), g1 = *(const f32x4*)(gp + 4);
            f32x4 cr[2][2];
#define ROPE_LOAD(g_) do { const int rt_ = ((g_) >> 2) * 128 + wr * 64 + ((g_) & 3) * 16 + fr, t_ = (pm * 256 + rt_) & (SEQ - 1); const int base_ = (wc >= 2) ? (128 * 32 + (t_ & 63) * 32) : ((t_ >> 6) * 32); \
                const f32x2* tp_ = tab + base_ + (wc & 1) * 16 + fq * 4; cr[(g_) & 1][0] = *(const f32x4*)(tp_); cr[(g_) & 1][1] = *(const f32x4*)(tp_ + 2); } while (0)
            if (pm < 64) { ROPE_LOAD(0); }
#pragma unroll
            for (int ai = 0; ai < 2; ++ai)
#pragma unroll
                for (int m = 0; m < 4; ++m) {
                    const int rt = ai * 128 + wr * 64 + m * 16 + fr, row = pm * 256 + rt;
                    f32x4 c0 = {1.f, 0.f, 1.f, 0.f}, c1 = {1.f, 0.f, 1.f, 0.f};
                    if (pm < 64) { c0 = cr[(ai * 4 + m) & 1][0]; c1 = cr[(ai * 4 + m) & 1][1]; }
                    if (pm < 64 && ai * 4 + m + 1 < 8) ROPE_LOAD(ai * 4 + m + 1);
#pragma unroll
                    for (int bj = 0; bj < 2; ++bj) {
                        const f32x4 p4 = *(const LAS f32x4*)(X + rt * 8 + bj * 4);
                        const float rn = __builtin_amdgcn_rsqf(((p4[0] + p4[1]) + (p4[2] + p4[3])) * (1.0f / 128.0f) + EPS);
                        f32x4 a = acc[ai][bj][m][0] * rn * g0, b = acc[ai][bj][m][1] * rn * g1;
                        f32x4 ra = {a[0] * c0[0] - a[1] * c0[1], a[1] * c0[0] + a[0] * c0[1], a[2] * c0[2] - a[3] * c0[3], a[3] * c0[2] + a[2] * c0[3]};
                        f32x4 rb = {b[0] * c1[0] - b[1] * c1[1], b[1] * c1[0] + b[0] * c1[1], b[2] * c1[2] - b[3] * c1[3], b[3] * c1[2] + b[2] * c1[3]};
                        u32x4 w; w.x = cvtpk(ra[0], ra[1]); w.y = cvtpk(ra[2], ra[3]); w.z = cvtpk(rb[0], rb[1]); w.w = cvtpk(rb[2], rb[3]);
                        if (pn < 2) st16_wt(Q + (size_t)row * 512 + pn * 256 + bj * 128 + c8, w);
                        else { const size_t krow = pm < 64 ? (size_t)(pm >> 5) * SKV + CTXL + (row & (SEQ - 1)) : (size_t)(pm - 64) * SKV + rt;
                            st16_wt(KA + krow * 256 + bj * 128 + c8, w); }
                    }
                    asm volatile("" ::: "memory");
                }
#undef ROPE_LOAD
        } else if (pn == 3) {
#pragma unroll
            for (int ai = 0; ai < 2; ++ai)
#pragma unroll
                for (int m = 0; m < 4; ++m) { const int rt = ai * 128 + wr * 64 + m * 16 + fr, row = pm * 256 + rt;
                    const size_t krow = pm < 64 ? (size_t)(pm >> 5) * SKV + CTXL + (row & (SEQ - 1)) : (size_t)(pm - 64) * SKV + rt;
#pragma unroll
                    for (int bj = 0; bj < 2; ++bj) { const f32x4 a = acc[ai][bj][m][0], b = acc[ai][bj][m][1];
                        u32x4 w; w.x = cvtpk(a[0], a[1]); w.y = cvtpk(a[2], a[3]); w.z = cvtpk(b[0], b[1]); w.w = cvtpk(b[2], b[3]);
                        st16_wt(VA + krow * 256 + bj * 128 + c8, w); } }
        } else if (pn <= 5) {
#pragma unroll
            for (int ai = 0; ai < 2; ++ai)
#pragma unroll
                for (int m = 0; m < 4; ++m) { const size_t row = (size_t)pm * 256 + ai * 128 + wr * 64 + m * 16 + fr;
#pragma unroll
                    for (int bj = 0; bj < 2; ++bj) { const f32x4 a = acc[ai][bj][m][0], b = acc[ai][bj][m][1];
                        u32x4 w; w.x = cvtpk(a[0], a[1]); w.y = cvtpk(a[2], a[3]); w.z = cvtpk(b[0], b[1]); w.w = cvtpk(b[2], b[3]);
                        st16_wt(BU + row * DM + (pn - 4) * 256 + bj * 128 + c8, w); } }
        } else {
#pragma unroll
            for (int ai = 0; ai < 2; ++ai)
#pragma unroll
                for (int m = 0; m < 4; ++m) { const size_t row = (size_t)pm * 256 + ai * 128 + wr * 64 + m * 16 + fr;
                    const f32x4 a = acc[ai][0][m][0] * acc[ai][1][m][0], b = acc[ai][0][m][1] * acc[ai][1][m][1];
                    u32x4 w; w.x = cvtpk(a[0], a[1]); w.y = cvtpk(a[2], a[3]); w.z = cvtpk(b[0], b[1]); w.w = cvtpk(b[2], b[3]);
                    st16_wt(BU + row * DM + 512 + (pn - 6) * 128 + c8, w); }
        }
    }
};

struct EpiResid {
    static constexpr bool PERM = false;
    unsigned char* wsb; const KArgs* kpb; int k, probe;
    template <int RIN, int OUTF>
    __device__ __forceinline__ void body(f32x4 (&acc)[2][2][4][2], const Unit& u, int wr, int wc, int fr, int fq, GAS unsigned char* ws, const KArgs* kp) const {
        float* xout = kp->out;
        const float* resid32 = nullptr; (void)resid32;
        const bf16_t* xb = (const bf16_t*)(ws + WS_XB);
        bf16_t* outb = (bf16_t*)(ws + ((probe && k != 3) ? WS_TOP : WS_XB));
        const int gate_i = k == 0 ? 2 * DM : (k == 1 ? 5 * DM : (k == 2 ? 3 * NMOD + 2 * DM : 3 * NMOD + 5 * DM));
        const float* gate = (const float*)(ws + WS_MODF) + gate_i;
        const int gstride = NMOD;
        const int has_next = (OUTF || probe) ? 0 : 1;
        float* ssq = (float*)(ws + WS_SSQ + (size_t)(k == 3 ? 0 : k) * SSQ_BYTES);
        const int pm = u.pm, pn = u.pn, b = pm >> 5;
        const int col0 = pn * 256 + wc * 32 + 4 * fq;
        float ssum[8];
#pragma unroll
        for (int gi = 0; gi < 8; ++gi) ssum[gi] = 0.f;
        f32x4 gva[2][2], gsa[2][2];
        const float* gsp = kp->pool_scale;
#pragma unroll
        for (int bj = 0; bj < 2; ++bj)
#pragma unroll
            for (int n = 0; n < 2; ++n) { const int c = col0 + bj * 128 + n * 16; gva[bj][n] = *(const f32x4*)(gate + b * gstride + c); gsa[bj][n] = *(const f32x4*)(gsp + c); }
        asm volatile("" ::: "memory");
#pragma unroll
        for (int bj = 0; bj < 2; ++bj)
#pragma unroll
            for (int n = 0; n < 2; ++n) gva[bj][n] = k == 2 ? gva[bj][n] * gsa[bj][n] : gva[bj][n];
#pragma unroll
        for (int bj = 0; bj < 2; ++bj) {
            f32x4 gv[2]; gv[0] = gva[bj][0]; gv[1] = gva[bj][1];
            typedef typename std::conditional<RIN == 0, f32x4, u32x2>::type rin_t;
            rin_t rb[4][2];
#define RES_LOAD(g_) do { int fr_o = fr; asm volatile("" : "+v"(fr_o)); const size_t rw_ = (size_t)pm * 256 + ((g_) >> 2) * 128 + wr * 64 + ((g_) & 3) * 16 + fr_o;       \
            _Pragma("unroll") for (int n = 0; n < 2; ++n) { const size_t o_ = rw_ * DM + col0 + bj * 128 + n * 16; \
                if constexpr (RIN == 0) rb[(g_) & 3][n] = *(const f32x4*)(resid32 + o_); else rb[(g_) & 3][n] = *(const u32x2*)(xb + o_); } } while (0)
            RES_LOAD(0); RES_LOAD(1); RES_LOAD(2);
#pragma unroll
            for (int gi = 0; gi < 8; ++gi) {
                const int ai = gi >> 2, m = gi & 3;
                int fr_s = fr; asm volatile("" : "+v"(fr_s));
                const size_t row = (size_t)pm * 256 + ai * 128 + wr * 64 + m * 16 + fr_s;
                if (gi + 3 < 8) RES_LOAD(gi + 3);
#pragma unroll
                for (int n = 0; n < 2; ++n) { const size_t off = row * DM + col0 + bj * 128 + n * 16;
                    f32x4 r;
                    if constexpr (RIN == 0) r = rb[gi & 3][n]; else { const u32x2 rw = rb[gi & 3][n]; r[0] = bflo(rw.x); r[1] = bfhi(rw.x); r[2] = bflo(rw.y); r[3] = bfhi(rw.y); }
                    const f32x4 o = r + gv[n] * acc[ai][bj][m][n];
                    if constexpr (OUTF) __builtin_nontemporal_store(o, (f32x4*)(xout + off));
                    else { u32x2 w_; w_.x = cvtpk(o[0], o[1]); w_.y = cvtpk(o[2], o[3]);
                        if (k == 1) *(u32x2*)(outb + off) = w_; else __builtin_nontemporal_store(w_, (u32x2*)(outb + off));
                        if (k == 1 && ((gi == 0 && wr == 0 && fr < 8) || (gi == 7 && wr == 1 && fr >= 8)))
                            *(u32x2*)((bf16_t*)(ws + WS_XE) + ((size_t)(pm * 4 + pn) * 16 + fr) * 256 + wc * 32 + 4 * fq + bj * 128 + n * 16) = w_; }
                    if (has_next) { ssum[gi] += (o[0] * o[0] + o[1] * o[1]) + (o[2] * o[2] + o[3] * o[3]); asm volatile("" : "+v"(ssum[gi])); } }
            }
#undef RES_LOAD
        }
        if (has_next) {
#pragma unroll
            for (int gi = 0; gi < 8; ++gi) { const size_t row = (size_t)pm * 256 + (gi >> 2) * 128 + wr * 64 + (gi & 3) * 16 + fr;
                float s = ssum[gi]; s += __shfl_xor(s, 16); s += __shfl_xor(s, 32); if (fq == 0) ssq[row * 16 + pn * 4 + wc] = s; }
        }
    }
    __device__ __forceinline__ void operator()(f32x4 (&acc)[2][2][4][2], const Unit& u, int wr_, int wc_, int fr_, int fq_, LAS unsigned char* xlds, int wid, int lane) const {
        int wr = wr_, wc = wc_; asm volatile("" : "+s"(wr), "+s"(wc));
        int ln_; asm volatile("v_mbcnt_lo_u32_b32 %0, -1, 0\n\tv_mbcnt_hi_u32_b32 %0, -1, %0" : "=v"(ln_));
        const int fr = ln_ & 15, fq = ln_ >> 4; (void)fr_; (void)fq_;
        GAS unsigned char* ws = (GAS unsigned char*)wsb; const KArgs* kp = kpb; asm volatile("" : "+s"(ws), "+s"(kp));
        if (k == 3) body<1, 1>(acc, u, wr, wc, fr, fq, ws, kp);
        else body<1, 0>(acc, u, wr, wc, fr, fq, ws, kp);
    }
};

__device__ __forceinline__ float dpp_f(float old, float src, int ctrl_sel) {
    const int o = __float_as_int(old), s = __float_as_int(src); int r;
    if (ctrl_sel == 0) r = __builtin_amdgcn_update_dpp(o, s, 0x111, 0xF, 0xF, false);
    else if (ctrl_sel == 1) r = __builtin_amdgcn_update_dpp(o, s, 0x101, 0xF, 0xF, false);
    else if (ctrl_sel == 2) r = __builtin_amdgcn_update_dpp(o, s, 0x121, 0xF, 0xF, false);
    else r = __builtin_amdgcn_update_dpp(o, s, 0x12F, 0xF, 0xF, false);
    return __int_as_float(r);
}
struct EpiFfnUp {
    static constexpr bool PERM = true;
    unsigned char* wsb; const KArgs* kpb; int l, cheap;
    __device__ __forceinline__ void operator()(f32x4 (&acc)[2][2][4][2], const Unit& u, int wr_, int wc_, int fr_, int fq_, LAS unsigned char* xlds, int wid, int lane) const {
        int wr = wr_, wc = wc_; asm volatile("" : "+s"(wr), "+s"(wc));
        int ln_; asm volatile("v_mbcnt_lo_u32_b32 %0, -1, 0\n\tv_mbcnt_hi_u32_b32 %0, -1, %0" : "=v"(ln_));
        const int fr = ln_ & 15, fq = ln_ >> 4; (void)fr_; (void)fq_;
        GAS unsigned char* ws = (GAS unsigned char*)wsb; const KArgs* kp = kpb; asm volatile("" : "+s"(ws), "+s"(kp));
        const float* ssq = (const float*)(ws + WS_SSQ + (size_t)(l ? 2 : 0) * SSQ_BYTES);
        const float* bias = (const float*)(ws + WS_BUP) + (size_t)l * 2 * NUP;
        const float* cw = kp->fconv_w + (size_t)l * 3 * DFF; const float* cb = kp->fconv_b + (size_t)l * DFF;
        bf16_t* H = (bf16_t*)(ws + WS_H); float* halo = (float*)(ws + WS_HALO);
        const int pm = u.pm, pn = u.pn, b = pm >> 5;
        const int c8 = wc * 32 + fq * 8, ch0 = pn * 128 + c8;
        if (cheap) {
#pragma unroll
            for (int ai = 0; ai < 2; ++ai)
#pragma unroll
                for (int m = 0; m < 4; ++m) { const size_t row = (size_t)pm * 256 + ai * 128 + wr * 64 + m * 16 + fr;
                    const f32x4 a = acc[ai][0][m][0] * acc[ai][1][m][0], c = acc[ai][0][m][1] * acc[ai][1][m][1];
                    u32x4 w; w.x = cvtpk(a[0], a[1]); w.y = cvtpk(a[2], a[3]); w.z = cvtpk(c[0], c[1]); w.w = cvtpk(c[2], c[3]);
                    *(u32x4*)(H + row * DFF + ch0) = w; }
            return;
        }
        const float* bp = bias + b * NUP + pn * 256 + c8;
        f32x4 bv[2][2], w0[2], w1[2], w2[2], cbv[2];
#pragma unroll
        for (int bj = 0; bj < 2; ++bj)
#pragma unroll
            for (int n = 0; n < 2; ++n) bv[bj][n] = *(const f32x4*)(bp + bj * 128 + 4 * n);
        LAS float* RS = (LAS float*)(xlds + 4096);
        volatile LAS int* RSPM = (volatile LAS int*)(xlds + 4096 + 1024);
        if (*RSPM != pm) {
            const int t = (wr * 4 + wc) * 64 + ln_, r = t >> 1, hf = t & 1; (void)wid; (void)lane;
            const f32x4* sp = (const f32x4*)(ssq + ((size_t)pm * 256 + r) * 16 + hf * 8); const f32x4 s0 = sp[0], s1 = sp[1];
            float tot = ((s0[0] + s0[1]) + (s0[2] + s0[3])) + ((s1[0] + s1[1]) + (s1[2] + s1[3]));
            tot += __shfl_xor(tot, 1);
            if (hf == 0) RS[r] = __builtin_amdgcn_rsqf(tot * (1.0f / DM) + EPS);
            EPI_BAR();
            if (t == 0) *RSPM = pm;
        }
#pragma unroll
        for (int ai = 0; ai < 2; ++ai)
#pragma unroll
            for (int m = 0; m < 4; ++m) { const float rs = RS[ai * 128 + wr * 64 + m * 16 + fr];
#pragma unroll
                for (int bj = 0; bj < 2; ++bj)
#pragma unroll
                    for (int n = 0; n < 2; ++n) acc[ai][bj][m][n] = acc[ai][bj][m][n] * rs + bv[bj][n]; }
        w0[0] = *(const f32x4*)(cw + ch0); w1[0] = *(const f32x4*)(cw + DFF + ch0); w2[0] = *(const f32x4*)(cw + 2 * DFF + ch0); cbv[0] = *(const f32x4*)(cb + ch0);
        LAS float* E = (LAS float*)xlds;
        if (fr == 0) {
#pragma unroll
            for (int ai = 0; ai < 2; ++ai)
#pragma unroll
                for (int n = 0; n < 2; ++n) *(LAS f32x4*)(E + ((ai * 2 + wr) * 2 + 0) * 128 + c8 + 4 * n) = acc[ai][0][0][n];
        }
        if (fr == 15) {
#pragma unroll
            for (int ai = 0; ai < 2; ++ai)
#pragma unroll
                for (int n = 0; n < 2; ++n) *(LAS f32x4*)(E + ((ai * 2 + wr) * 2 + 1) * 128 + c8 + 4 * n) = acc[ai][0][3][n];
        }
        EPI_BAR();
        w0[1] = *(const f32x4*)(cw + ch0 + 4); w1[1] = *(const f32x4*)(cw + DFF + ch0 + 4); w2[1] = *(const f32x4*)(cw + 2 * DFF + ch0 + 4); cbv[1] = *(const f32x4*)(cb + ch0 + 4);
        u32x2 hp0[4];
#pragma unroll
        for (int ai = 0; ai < 2; ++ai) {
#pragma unroll
            for (int n = 0; n < 2; ++n) {
                const int blk = ai * 2 + wr;
                const f32x4 eprev = blk > 0 ? *(const LAS f32x4*)(E + ((blk - 1) * 2 + 1) * 128 + c8 + 4 * n) : (f32x4){0.f, 0.f, 0.f, 0.f};
                const f32x4 enext = blk < 3 ? *(const LAS f32x4*)(E + ((blk + 1) * 2 + 0) * 128 + c8 + 4 * n) : (f32x4){0.f, 0.f, 0.f, 0.f};
#pragma unroll
                for (int m = 0; m < 4; ++m) {
                    const int rt = ai * 128 + wr * 64 + m * 16 + fr; const size_t row = (size_t)pm * 256 + rt;
                    f32x4 hv, pc;
#pragma unroll
                    for (int j = 0; j < 4; ++j) {
                        const float g = acc[ai][0][m][n][j];
                        float upe, dne;
                        if (m > 0) upe = dpp_f(0.f, acc[ai][0][m - 1][n][j], 2); else upe = eprev[j];
                        if (m < 3) dne = dpp_f(0.f, acc[ai][0][m + 1][n][j], 3); else dne = enext[j];
                        const float up = dpp_f(upe, g, 0), dn = dpp_f(dne, g, 1);
                        const float cv = w0[n][j] * up + w1[n][j] * g + w2[n][j] * dn + cbv[n][j];
                        pc[j] = cv; hv[j] = silu_f(cv) * acc[ai][1][m][n][j];
                    }
                    if (n == 0) { hp0[m].x = cvtpk(hv[0], hv[1]); hp0[m].y = cvtpk(hv[2], hv[3]); }
                    else { u32x4 w; w.x = hp0[m].x; w.y = hp0[m].y; w.z = cvtpk(hv[0], hv[1]); w.w = cvtpk(hv[2], hv[3]);
                        st16_wt(H + row * DFF + ch0, w); }
                    if ((m == 0 && blk == 0 && fr == 0) || (m == 3 && blk == 3 && fr == 15)) {
                        float* hp = halo + ((size_t)(pm * 22 + pn) * 6 + (m == 0 ? 0 : 3)) * 128 + c8 + 4 * n;
                        *(f32x4*)(hp) = pc; *(f32x4*)(hp + 128) = acc[ai][1][m][n]; *(f32x4*)(hp + 256) = acc[ai][0][m][n];
                    }
                }
                asm volatile("" ::: "memory");
            }
        }
    }
};
}

namespace attn {
using bf16 = __hip_bfloat16;
using s16x4 = __attribute__((ext_vector_type(4))) short;
using f32x16 = __attribute__((ext_vector_type(16))) float;
constexpr int D = 128, NW = 8, QBLK = 32, KVBLK = 64;
constexpr float SCALE = 0.088388347648318440f;
constexpr float THR = 8.f;
constexpr int LDQ = 512, LDK = 256, LDO = 1024;
constexpr size_t SHM_V = KVBLK * D * 2, SHM_K = KVBLK * D * 2, SHM_ATTN = 2 * SHM_V + 2 * SHM_K + NW * 64 * 4;
#define KSWZ(row, colB) ((row) * 256 + ((colB) ^ (((row) & 7) << 4)))
#define SBAR() __builtin_amdgcn_sched_barrier(0)
__device__ __forceinline__ int crow(int r, int hi) { return (r & 3) + 8 * (r >> 2) + 4 * hi; }
__device__ __forceinline__ unsigned cvtpk_a(float lo, float hi) { unsigned r; asm volatile("v_cvt_pk_bf16_f32 %0, %1, %2" : "=v"(r) : "v"(lo), "v"(hi)); return r; }
__device__ __forceinline__ bf16x8 ld8(const bf16* p) { return *reinterpret_cast<const bf16x8*>(p); }

__device__ __forceinline__ void partialSM(f32x16& p0, f32x16& p1, float& m_reg, float& mn, float& alpha) {
  constexpr float C = SCALE * 1.4426950408889634f;
  float pmax = p0[0]; for (int r = 1; r < 16; ++r) pmax = fmaxf(pmax, p0[r]); for (int r = 0; r < 16; ++r) pmax = fmaxf(pmax, p1[r]);
  { auto rr = __builtin_amdgcn_permlane32_swap(__float_as_uint(pmax), __float_as_uint(pmax), false, false);
    pmax = fmaxf(__uint_as_float(rr[0]), __uint_as_float(rr[1])); }
  if (__builtin_expect(__all(pmax - m_reg <= THR / SCALE), 1)) { mn = m_reg; alpha = 1.f; }
  else { mn = fmaxf(m_reg, pmax); alpha = __builtin_amdgcn_exp2f((m_reg - mn) * C); m_reg = mn; }
  float mnC = -mn * C;
  for (int r = 0; r < 16; ++r) p0[r] = fmaf(p0[r], C, mnC); for (int r = 0; r < 16; ++r) p1[r] = fmaf(p1[r], C, mnC);
  for (int r = 0; r < 16; ++r) p0[r] = __builtin_amdgcn_exp2f(p0[r]);
}
__device__ __forceinline__ void finishSM(f32x16& p0, f32x16& p1, float alpha, float& l_reg, bf16x8& pa0, bf16x8& pa1, bf16x8& pa2, bf16x8& pa3) {
  for (int r = 0; r < 16; ++r) p1[r] = __builtin_amdgcn_exp2f(p1[r]);
  float ps = 0; for (int r = 0; r < 16; ++r) ps += p0[r]; for (int r = 0; r < 16; ++r) ps += p1[r];
  { auto rr = __builtin_amdgcn_permlane32_swap(__float_as_uint(ps), __float_as_uint(ps), false, false);
    ps = __uint_as_float(rr[0]) + __uint_as_float(rr[1]); }
  l_reg = l_reg * alpha + ps;
#define PK4(P, BASE, OUT) do { unsigned a0 = cvtpk_a(P[BASE + 0], P[BASE + 1]), a1 = cvtpk_a(P[BASE + 2], P[BASE + 3]);   \
    unsigned b0 = cvtpk_a(P[BASE + 4], P[BASE + 5]), b1 = cvtpk_a(P[BASE + 6], P[BASE + 7]);                              \
    auto r0 = __builtin_amdgcn_permlane32_swap(a0, b0, false, false); auto r1 = __builtin_amdgcn_permlane32_swap(a1, b1, false, false); \
    u32x4 w = {r0[0], r1[0], r0[1], r1[1]}; OUT = *reinterpret_cast<bf16x8*>(&w); } while (0)
  PK4(p0, 0, pa0); PK4(p0, 8, pa1); PK4(p1, 0, pa2); PK4(p1, 8, pa3);
#undef PK4
}
__device__ __forceinline__ void qkt(f32x16& p0, f32x16& p1, const bf16* Ks, const bf16x8* qr, int r32, int hi) {
  p0 = f32x16{}; p1 = f32x16{};
  for (int d0 = 0; d0 < 8; ++d0) { int cb = (d0 * 16 + hi * 8) * 2;
    bf16x8 b0 = *reinterpret_cast<const bf16x8*>((const char*)Ks + KSWZ(r32, cb));
    bf16x8 b1 = *reinterpret_cast<const bf16x8*>((const char*)Ks + KSWZ(32 + r32, cb));
    p0 = __builtin_amdgcn_mfma_f32_32x32x16_bf16(b0, qr[d0], p0, 0, 0, 0);
    p1 = __builtin_amdgcn_mfma_f32_32x32x16_bf16(b1, qr[d0], p1, 0, 0, 0); }
}
__device__ __forceinline__ int v_st(int k, int c) { const int kk = (k & ~0xC) | ((k & 4) << 1) | ((k & 8) >> 1); return ((kk >> 3) * 4 + (c >> 5)) * 512 + ((kk & 7) * 32 + (c & 31)) * 2; }
__device__ __forceinline__ int v_rd_base(int lane) { return ((lane & 3) << 3) | (((lane >> 2) & 3) << 6) | (((lane >> 4) & 1) << 5) | (((lane >> 5) & 1) << 8); }
constexpr int v_rd_off(int d0, int ks, int half) { return d0 * 512 + ks * 4096 + half * 2048; }
template <int OFF> __device__ __forceinline__ s16x4 tr_read(int vb) {
  s16x4 r; asm volatile("ds_read_b64_tr_b16 %0, %1 offset:%2" : "=&v"(r) : "v"(vb), "i"(OFF) : "memory"); return r;
}
template <int D0> __device__ __forceinline__ void pv_one(f32x16& od, int vb, bf16x8 pa0, bf16x8 pa1, bf16x8 pa2, bf16x8 pa3) {
  const s16x4 l0 = tr_read<v_rd_off(D0, 0, 0)>(vb), h0 = tr_read<v_rd_off(D0, 0, 1)>(vb), l1 = tr_read<v_rd_off(D0, 1, 0)>(vb), h1 = tr_read<v_rd_off(D0, 1, 1)>(vb);
  const s16x4 l2 = tr_read<v_rd_off(D0, 2, 0)>(vb), h2 = tr_read<v_rd_off(D0, 2, 1)>(vb), l3 = tr_read<v_rd_off(D0, 3, 0)>(vb), h3 = tr_read<v_rd_off(D0, 3, 1)>(vb);
  asm volatile("s_waitcnt lgkmcnt(0)" ::: "memory"); SBAR();
#define PK(L, H) (bf16x8){L[0], L[1], L[2], L[3], H[0], H[1], H[2], H[3]}
  od = __builtin_amdgcn_mfma_f32_32x32x16_bf16(pa0, PK(l0, h0), od, 0, 0, 0);
  od = __builtin_amdgcn_mfma_f32_32x32x16_bf16(pa1, PK(l1, h1), od, 0, 0, 0);
  od = __builtin_amdgcn_mfma_f32_32x32x16_bf16(pa2, PK(l2, h2), od, 0, 0, 0);
  od = __builtin_amdgcn_mfma_f32_32x32x16_bf16(pa3, PK(l3, h3), od, 0, 0, 0);
#undef PK
}
__device__ __forceinline__ void pv_d0(f32x16* o, int vb, bf16x8 pa0, bf16x8 pa1, bf16x8 pa2, bf16x8 pa3) {
  pv_one<0>(o[0], vb, pa0, pa1, pa2, pa3); pv_one<1>(o[1], vb, pa0, pa1, pa2, pa3); pv_one<2>(o[2], vb, pa0, pa1, pa2, pa3); pv_one<3>(o[3], vb, pa0, pa1, pa2, pa3);
}

__device__ __forceinline__ void attn_dense_body(const bf16* Qb, const bf16* Kh, const bf16* Vh, bf16* Ob, int seq, char* lds, const int tid) {
  const int wid = tid >> 6, lane = tid & 63, r32 = lane & 31, hi = lane >> 5;
  bf16* V_lds = (bf16*)lds; bf16* K_lds = (bf16*)(lds + 2 * SHM_V);
  float* ws = (float*)(lds + 2 * SHM_V + 2 * SHM_K) + wid * 64; float* li_l = ws; float* al_l = ws + 32;
  float m_reg = -1e30f, l_reg = 0; f32x16 o[4] = {}; bf16x8 qr[8];
  const bf16* Qw = Qb + (long)(wid * QBLK + r32) * LDQ + hi * 8;
#pragma unroll
  for (int d0 = 0; d0 < 8; ++d0) qr[d0] = ld8(Qw + d0 * 16);
  const int sr = tid >> 4, sc = (tid & 15) * 8, vst0 = v_st(sr, sc), vst1 = v_st(32 + sr, sc);
  const int vb0 = (int)(uintptr_t)V_lds + v_rd_base(lane);
  struct { bf16x8 vs0, vs1, ks0, ks1; } sr_[2];
  const unsigned lo0 = (unsigned)((sr * LDK + sc) * 2), lo1 = lo0 + (unsigned)(32 * LDK * 2);
#define SLOAD(i, k0) do { const char* vt_ = (const char*)Vh + (size_t)(k0) * (LDK * 2); const char* kt_ = (const char*)Kh + (size_t)(k0) * (LDK * 2); \
    sr_[i].vs0 = *(const bf16x8*)(vt_ + lo0); sr_[i].vs1 = *(const bf16x8*)(vt_ + lo1); \
    sr_[i].ks0 = *(const bf16x8*)(kt_ + lo0); sr_[i].ks1 = *(const bf16x8*)(kt_ + lo1); } while (0)
#define SWRITE(b, i) do { *(bf16x8*)((char*)V_lds + (b) * SHM_V + vst0) = sr_[i].vs0;          \
    *(bf16x8*)((char*)V_lds + (b) * SHM_V + vst1) = sr_[i].vs1; int kc = sc * 2;               \
    *(bf16x8*)((char*)K_lds + (b) * SHM_K + KSWZ(sr, kc)) = sr_[i].ks0;                       \
    *(bf16x8*)((char*)K_lds + (b) * SHM_K + KSWZ(32 + sr, kc)) = sr_[i].ks1; } while (0)
#define SWAIT() asm volatile("s_waitcnt vmcnt(4)" ::: "memory")
#define RESC(a) do { if (__any((a) < 1.f)) { if (hi == 0) al_l[r32] = (a); asm volatile("s_waitcnt lgkmcnt(0)" ::: "memory"); \
    for (int d = 0; d < 4; ++d) for (int r = 0; r < 16; ++r) o[d][r] *= al_l[crow(r, hi)]; } } while (0)
  f32x16 pA0, pA1, pB0, pB1; float mnA, mnB, alA, alB; bf16x8 pa0, pa1, pa2, pa3; const int NT = seq / KVBLK;
  constexpr int SE = 0, SO = 1;
  SLOAD(SE, 0); asm volatile("s_waitcnt vmcnt(0)" ::: "memory"); SWRITE(0, SE); __syncthreads();
  qkt(pA0, pA1, K_lds, qr, r32, hi); partialSM(pA0, pA1, m_reg, mnA, alA);
  SLOAD(SO, KVBLK); if (2 < NT) SLOAD(SE, 2 * KVBLK);
  SWAIT(); SWRITE(1, SO); __syncthreads();
  for (int j = 1; j + 1 < NT; j += 2) {
    SBAR(); qkt(pB0, pB1, (bf16*)((char*)K_lds + SHM_K), qr, r32, hi);
    finishSM(pA0, pA1, alA, l_reg, pa0, pa1, pa2, pa3); SBAR();
    SLOAD(SO, (j + 2) * KVBLK); SBAR();
    pv_d0(o, vb0, pa0, pa1, pa2, pa3); partialSM(pB0, pB1, m_reg, mnB, alB);
    __syncthreads(); SWAIT(); SWRITE(0, SE);
    RESC(alB); __syncthreads();
    SBAR(); qkt(pA0, pA1, K_lds, qr, r32, hi);
    finishSM(pB0, pB1, alB, l_reg, pa0, pa1, pa2, pa3); SBAR();
    if (j + 3 < NT) SLOAD(SE, (j + 3) * KVBLK); SBAR();
    pv_d0(o, vb0 + (int)SHM_V, pa0, pa1, pa2, pa3); partialSM(pA0, pA1, m_reg, mnA, alA);
    __syncthreads(); SWAIT(); SWRITE(1, SO);
    RESC(alA); __syncthreads();
  }
  SBAR(); qkt(pB0, pB1, (bf16*)((char*)K_lds + SHM_K), qr, r32, hi);
  finishSM(pA0, pA1, alA, l_reg, pa0, pa1, pa2, pa3); SBAR();
  pv_d0(o, vb0, pa0, pa1, pa2, pa3); partialSM(pB0, pB1, m_reg, mnB, alB);
  __syncthreads(); RESC(alB);
  finishSM(pB0, pB1, alB, l_reg, pa0, pa1, pa2, pa3); SBAR();
  pv_d0(o, vb0 + (int)SHM_V, pa0, pa1, pa2, pa3);
  if (hi == 0) li_l[r32] = l_reg; asm volatile("s_waitcnt lgkmcnt(0)" ::: "memory");
  float rli[16];
#pragma unroll
  for (int r = 0; r < 16; ++r) rli[r] = __builtin_amdgcn_rcpf(li_l[crow(r, hi)]);
  { int r32e = r32, hie = hi; asm volatile("" : "+v"(r32e), "+v"(hie));
    bf16* Ow = Ob + (wid * QBLK + 4 * hie) * LDO + r32e;
#pragma unroll
    for (int r = 0; r < 16; ++r) { const int orow = (r & 3) + 8 * (r >> 2);
#pragma unroll
      for (int d0 = 0; d0 < 4; ++d0) Ow[orow * LDO + d0 * 32] = __float2bfloat16(o[d0][r] * rli[r]); } }
#undef SLOAD
#undef SWRITE
#undef SWAIT
#undef RESC
}
#undef KSWZ
#undef SBAR
}

#define XB_TMO      128
#define XB_XCNT(j)  (256  + 64 * (j))
#define XB_XSUB(j)  (1280 + 64 * (j))
#define XB_XGEN(j)  (2304 + 64 * (j))
#define XB_TOP      3328
#define XB_TOPGEN   3392
#define XCD_BAR_WORDS 3456
#define XB_SPIN_CAP (1u << 18)
__device__ __forceinline__ unsigned xb_ld(unsigned* p)              { return __hip_atomic_load(p, __ATOMIC_RELAXED, __HIP_MEMORY_SCOPE_AGENT); }
__device__ __forceinline__ unsigned xb_add(unsigned* p, unsigned v) { return __hip_atomic_fetch_add(p, v, __ATOMIC_RELAXED, __HIP_MEMORY_SCOPE_AGENT); }
__device__ __forceinline__ unsigned xb_xcc_id() { return (unsigned)__builtin_amdgcn_s_getreg((3 << 11) | 20) & 0xFu; }
#define XB_SPIN(cond, bar) do { unsigned _sp = 0; while (cond) { __builtin_amdgcn_s_sleep(1); \
    if ((++_sp & 255u) == 0u) { if (xb_ld(&(bar)[XB_TMO])) break; if (_sp > XB_SPIN_CAP) { atomicAdd(&(bar)[XB_TMO], 1u); break; } } } } while (0)
struct XcdBarrier { unsigned* bar; unsigned x; unsigned G; volatile LAS unsigned* st; };
__device__ __forceinline__ XcdBarrier xcd_barrier_post(unsigned* bar, volatile LAS unsigned* st, unsigned G, bool t0) {
    XcdBarrier b; b.bar = bar; b.x = xb_xcc_id(); b.st = st; b.G = G;
    if (t0) (void)xb_add(&bar[XB_XCNT(b.x)], 1u);
    return b;
}
__device__ __forceinline__ void xcd_barrier_complete(unsigned* bar, unsigned x, unsigned G, unsigned& nloc, unsigned& nx) {
    unsigned sum, cnt, mine, sp = 0u;
    for (;;) {
        sum = 0u; cnt = 0u; mine = 0u;
#pragma unroll
        for (unsigned j = 0; j < 16; ++j) { const unsigned c = xb_ld(&bar[XB_XCNT(j)]); sum += c; cnt += (c > 0u) ? 1u : 0u; mine = (j == x) ? c : mine; }
        if (sum == G) break;
        __builtin_amdgcn_s_sleep(1);
        if ((++sp & 255u) == 0u) { if (xb_ld(&bar[XB_TMO])) break; if (sp > XB_SPIN_CAP) { atomicAdd(&bar[XB_TMO], 1u); break; } }
    }
    nloc = mine > 0u ? mine : 1u; nx = cnt > 0u ? cnt : 1u;
}
__device__ __forceinline__ void xcd_barrier(const XcdBarrier& b, bool t0) {
    asm volatile("s_waitcnt vmcnt(0)" ::: "memory");
    __syncthreads();
    if (t0) {
        unsigned* bar = b.bar;
        __builtin_amdgcn_s_waitcnt(0);
        unsigned nloc = b.st[0], nx = b.st[1];
        if (nloc == 0u) { xcd_barrier_complete(bar, b.x, b.G, nloc, nx); b.st[0] = nloc; b.st[1] = nx; }
        const unsigned old = xb_add(&bar[XB_XSUB(b.x)], 1u);
        const unsigned gen = old / nloc;
        if (old + 1u == (gen + 1u) * nloc) {
            __builtin_amdgcn_fence(__ATOMIC_RELEASE, "agent");
            asm volatile("s_waitcnt vmcnt(0)" ::: "memory");
            const unsigned og = xb_add(&bar[XB_TOP], 1u);
            const unsigned tg = og / nx;
            if (og + 1u == (tg + 1u) * nx) xb_add(&bar[XB_TOPGEN], 1u);
            else XB_SPIN(xb_ld(&bar[XB_TOPGEN]) == tg, bar);
            __builtin_amdgcn_fence(__ATOMIC_ACQUIRE, "agent");
            xb_add(&bar[XB_XGEN(b.x)], 1u);
            asm volatile("s_waitcnt vmcnt(0)" ::: "memory");
        } else {
            XB_SPIN(xb_ld(&bar[XB_XGEN(b.x)]) == gen, bar);
            __builtin_amdgcn_fence(__ATOMIC_ACQUIRE, "agent");
            asm volatile("s_waitcnt vmcnt(0)" ::: "memory");
        }
    }
    __syncthreads();
}


template <int NV>
__device__ __forceinline__ float gemv64(const float* W, int ldw, int col0, const LAS float* vecs, LAS float* red, int tid) {
    const int cg = tid & 15, kg = tid >> 4;
    f32x4 a[NV];
#pragma unroll
    for (int v = 0; v < NV; ++v) a[v] = (f32x4){0.f, 0.f, 0.f, 0.f};
    const float* wp = W + (size_t)kg * ldw + col0 + cg * 4;
    f32x4 w[32];
#pragma unroll
    for (int i = 0; i < 32; ++i) w[i] = __builtin_nontemporal_load((const f32x4*)(wp + (size_t)i * 32 * ldw));
    asm volatile("" ::: "memory");
#pragma unroll
    for (int i = 0; i < 32; ++i) { const int k = kg + 32 * i;
#pragma unroll
        for (int v = 0; v < NV; ++v) a[v] += w[i] * vecs[v * 1024 + k]; }
#pragma unroll
    for (int v = 0; v < NV; ++v) *(LAS f32x4*)(red + (kg * 16 + cg) * (4 * NV) + v * 4) = a[v];
    LDS_WAIT(); __syncthreads();
    float s = 0.f;
    if (tid < 64 * NV) { const int v = tid >> 6, c = tid & 63;
#pragma unroll 8
        for (int g = 0; g < 32; ++g) s += red[(g * 16 + (c >> 2)) * (4 * NV) + v * 4 + (c & 3)]; }
    __syncthreads();
    return s;
}

template <int MAP>
__device__ __forceinline__ void transpose_item(const float* W, int K, int N, bf16_t* WT, LAS float* scr, int item, int lane) {
    const int nblk = N / 32, kb = item / nblk, nb = item % nblk, k0 = 64 * kb, n0 = 32 * nb;
    f32x4 v[8];
#pragma unroll
    for (int i = 0; i < 8; ++i) v[i] = __builtin_nontemporal_load((const f32x4*)(W + (size_t)(k0 + 8 * i + (lane >> 3)) * N + n0 + 4 * (lane & 7)));
#pragma unroll
    for (int i = 0; i < 8; ++i) { LAS float* d = scr + (8 * i + (lane >> 3)) * 33 + 4 * (lane & 7); d[0] = v[i][0]; d[1] = v[i][1]; d[2] = v[i][2]; d[3] = v[i][3]; }
    LDS_WAIT(); asm volatile("" ::: "memory");
    const int c = lane & 7;
#pragma unroll
    for (int j = 0; j < 4; ++j) { const int n = (lane >> 3) + 8 * j; const LAS float* sp = scr + (8 * c) * 33 + n;
        u32x4 o; o.x = cvtpk(sp[0 * 33], sp[1 * 33]); o.y = cvtpk(sp[2 * 33], sp[3 * 33]); o.z = cvtpk(sp[4 * 33], sp[5 * 33]); o.w = cvtpk(sp[6 * 33], sp[7 * 33]);
        const int src = n0 + n; const int dst = MAP == 1 ? map_in(src) : (MAP == 2 ? map_up(src) : src);
        *(u32x4*)(WT + (size_t)dst * K + k0 + 8 * c) = o; }
    LDS_WAIT(); asm volatile("" ::: "memory");
}


template <int HW>
__device__ __forceinline__ void pool_rows32(const bf16_t* xb, const bf16_t* xe_prev, const bf16_t* xe_next, int tile0, int t0, float rs_l, f32x4 nv, bf16_t* dst) {
    constexpr int NW = 8 + 2 * HW;
#define PR_PTR(t) ({ const int tc_ = (t) < 0 ? 0 : ((t) >= SEQ ? SEQ - 1 : (t)); const int tl_ = tc_ - tile0; \
        (tl_ < 0) ? xe_prev + (size_t)(16 + tl_) * 256 : ((tl_ >= 256) ? xe_next + (size_t)(tl_ - 256) * 256 : xb + (size_t)tc_ * DM); })
#define PR_RS(t) __int_as_float(__builtin_amdgcn_readlane(__float_as_int(rs_l), (t) - t0 + 8))
#define PR_CVT(w_) ((f32x4){bflo((w_).x), bfhi((w_).x), bflo((w_).y), bfhi((w_).y)})
    f32x4 win[NW]; u32x2 raw[NW + 24];
#pragma unroll
    for (int j = 0; j < NW + 24; ++j) raw[j] = *(const u32x2*)PR_PTR(t0 - HW + j);
#pragma unroll
    for (int j = 0; j < NW; ++j) win[j] = PR_CVT(raw[j]) * PR_RS(t0 - HW + j);
#pragma unroll
    for (int blk = 0; blk < 4; ++blk) {
        f32x4 S = win[0];
#pragma unroll
        for (int j = 1; j < 2 * HW; ++j) S += win[j];
#pragma unroll
        for (int o = 0; o < 8; ++o) { const int t = t0 + 8 * blk + o;
            const int a0 = t - HW < 0 ? 0 : t - HW, e0 = t + HW > SEQ ? SEQ : t + HW;
            const f32x4 pv = (S * (1.0f / (float)(e0 - a0)) - win[o + HW]) * nv;
            u32x2 w; w.x = cvtpk(pv[0], pv[1]); w.y = cvtpk(pv[2], pv[3]);
            *(u32x2*)(dst + (size_t)t * DM) = w;
            S += win[o + 2 * HW]; S -= win[o]; }
        if (blk < 3) {
#pragma unroll
            for (int j = 0; j < 2 * HW; ++j) win[j] = win[j + 8];
#pragma unroll
            for (int j = 0; j < 8; ++j) win[2 * HW + j] = PR_CVT(raw[NW + 8 * blk + j]) * PR_RS(t0 - HW + 8 * (blk + 1) + 2 * HW + j);
        }
    }
#undef PR_PTR
#undef PR_RS
#undef PR_CVT
}

__device__ __forceinline__ void transpose_item_in(const float* W, bf16_t* WT, const float* nrm, const float* sc0, LAS float* scr, int item, int lane) {
    constexpr int K = DM, N = NIN;
    const int nblk = N / 32, kb = item / nblk, nb = item % nblk, k0 = 64 * kb, n0 = 32 * nb;
    f32x4 v[8];
#pragma unroll
    for (int i = 0; i < 8; ++i) v[i] = __builtin_nontemporal_load((const f32x4*)(W + (size_t)(k0 + 8 * i + (lane >> 3)) * N + n0 + 4 * (lane & 7)));
    const int c = lane & 7;
    const f32x4 na = *(const f32x4*)(nrm + k0 + 8 * c), nb4 = *(const f32x4*)(nrm + k0 + 8 * c + 4);
#pragma unroll
    for (int i = 0; i < 8; ++i) { LAS float* d = scr + (8 * i + (lane >> 3)) * 33 + 4 * (lane & 7); d[0] = v[i][0]; d[1] = v[i][1]; d[2] = v[i][2]; d[3] = v[i][3]; }
    LDS_WAIT(); asm volatile("" ::: "memory");
#pragma unroll
    for (int vv = 0; vv < 3; ++vv) {
        const float* sc = sc0 + (size_t)vv * NMOD;
        const f32x4 sa = na * (1.0f + *(const f32x4*)(sc + k0 + 8 * c)), sb = nb4 * (1.0f + *(const f32x4*)(sc + k0 + 8 * c + 4));
#pragma unroll
        for (int j = 0; j < 4; ++j) { const int n = (lane >> 3) + 8 * j; const LAS float* sp = scr + (8 * c) * 33 + n;
            u32x4 o; o.x = cvtpk(sp[0 * 33] * sa[0], sp[1 * 33] * sa[1]); o.y = cvtpk(sp[2 * 33] * sa[2], sp[3 * 33] * sa[3]); o.z = cvtpk(sp[4 * 33] * sb[0], sp[5 * 33] * sb[1]); o.w = cvtpk(sp[6 * 33] * sb[2], sp[7 * 33] * sb[3]);
            *(u32x4*)(WT + (size_t)vv * N * K + (size_t)map_in(n0 + n) * K + k0 + 8 * c) = o; }
    }
    LDS_WAIT(); asm volatile("" ::: "memory");
}
__device__ __forceinline__ void transpose_item_up(const float* W, bf16_t* WT, const float* nrm, const float* sc0, const float* sc1, LAS float* scr, int item, int lane) {
    constexpr int K = DM, N = NUP;
    const int nblk = N / 32, kb = item / nblk, nb = item % nblk, k0 = 64 * kb, n0 = 32 * nb;
    f32x4 v[8];
#pragma unroll
    for (int i = 0; i < 8; ++i) v[i] = __builtin_nontemporal_load((const f32x4*)(W + (size_t)(k0 + 8 * i + (lane >> 3)) * N + n0 + 4 * (lane & 7)));
    const int c = lane & 7;
    const f32x4 na = *(const f32x4*)(nrm + k0 + 8 * c), nb4 = *(const f32x4*)(nrm + k0 + 8 * c + 4);
    const f32x4 s0a = na * (1.0f + *(const f32x4*)(sc0 + k0 + 8 * c)), s0b = nb4 * (1.0f + *(const f32x4*)(sc0 + k0 + 8 * c + 4));
    const f32x4 s1a = na * (1.0f + *(const f32x4*)(sc1 + k0 + 8 * c)), s1b = nb4 * (1.0f + *(const f32x4*)(sc1 + k0 + 8 * c + 4));
#pragma unroll
    for (int i = 0; i < 8; ++i) { LAS float* d = scr + (8 * i + (lane >> 3)) * 33 + 4 * (lane & 7); d[0] = v[i][0]; d[1] = v[i][1]; d[2] = v[i][2]; d[3] = v[i][3]; }
    LDS_WAIT(); asm volatile("" ::: "memory");
#pragma unroll
    for (int j = 0; j < 4; ++j) { const int n = (lane >> 3) + 8 * j; const LAS float* sp = scr + (8 * c) * 33 + n;
        const float w0 = sp[0 * 33], w1 = sp[1 * 33], w2 = sp[2 * 33], w3 = sp[3 * 33], w4 = sp[4 * 33], w5 = sp[5 * 33], w6 = sp[6 * 33], w7 = sp[7 * 33];
        u32x4 o0, o1;
        o0.x = cvtpk(w0 * s0a[0], w1 * s0a[1]); o0.y = cvtpk(w2 * s0a[2], w3 * s0a[3]); o0.z = cvtpk(w4 * s0b[0], w5 * s0b[1]); o0.w = cvtpk(w6 * s0b[2], w7 * s0b[3]);
        o1.x = cvtpk(w0 * s1a[0], w1 * s1a[1]); o1.y = cvtpk(w2 * s1a[2], w3 * s1a[3]); o1.z = cvtpk(w4 * s1b[0], w5 * s1b[1]); o1.w = cvtpk(w6 * s1b[2], w7 * s1b[3]);
        const int dst = map_up(n0 + n);
        *(u32x4*)(WT + (size_t)dst * K + k0 + 8 * c) = o0;
        *(u32x4*)(WT + (size_t)N * K + (size_t)dst * K + k0 + 8 * c) = o1; }
    LDS_WAIT(); asm volatile("" ::: "memory");
}

constexpr int I_IN = (DM / 64) * (NIN / 32), I_OUT = (DM / 64) * (DM / 32), I_POOL = (256 / 64) * (256 / 32), I_UP = (DM / 64) * (NUP / 32), I_DN = (DFF / 64) * (DM / 32);
constexpr int IT_OUT = I_IN, IT_POOL = IT_OUT + I_OUT, IT_UP = IT_POOL + 4 * I_POOL, IT_DN = IT_UP + 2 * I_UP, IT_END = IT_DN + 2 * I_DN;
#ifndef PH_MASK
#define PH_MASK 0xFFFF
#endif
#define PHM(x) (((PH_MASK) >> (x)) & 1)
enum Phase { PH_MOD = 0, PH_PREP, PH_INPROJ, PH_ATTN, PH_OUTPROJ, PH_UP0, PH_DOWN0, PH_POOLG, PH_UP1, PH_DOWN1, PH_COUNT };

__global__ void __launch_bounds__(NTHREADS, 2) fwd_kernel(Args args) {
    __shared__ __attribute__((aligned(16))) unsigned char lds_raw[LDS_BYTES];
    LAS unsigned char* lds = (LAS unsigned char*)lds_raw;
    LAS unsigned char* xlds = lds + XCH_OFF;
    volatile LAS unsigned* MISC = (volatile LAS unsigned*)(lds + MISC_OFF);
    const int G = args.grid, bid = blockIdx.x;
    const int vcu = (G % 8 == 0) ? (bid % 8) * (G / 8) + bid / 8 : bid;
    const int wave_s = __builtin_amdgcn_readfirstlane((int)threadIdx.x >> 6);
#define TID_NOW() ({ int l_; asm volatile("v_mbcnt_lo_u32_b32 %0, -1, 0\n\tv_mbcnt_hi_u32_b32 %0, -1, %0" : "=v"(l_)); wave_s * 64 + l_; })
    for (int u = TID_NOW(); u < 64; u += NTHREADS) MISC[u] = 0u;
    __syncthreads();
    const int lo = args.ph_lo, hi = args.ph_hi;
    const bool use_bar = (hi - lo) > 1;
    XcdBarrier bar; bar.bar = (unsigned*)(args.ws + WS_CTL) + 4096; bar.x = 0; bar.G = (unsigned)G; bar.st = MISC + 8;
    if (use_bar) bar = xcd_barrier_post((unsigned*)(args.ws + WS_CTL) + 4096, MISC + 8, (unsigned)G, TID_NOW() == 0);

#define TRANSPOSE_IT(it_) do { int r_ = (it_); \
        if (r_ < IT_OUT) { transpose_item_in(kp->w_in, Win_t, kp->mix_norm, modf + DM, scr, r_, lane); } \
        else if (r_ < IT_POOL) { transpose_item<0>(kp->w_out, DM, DM, Wout_t, scr, r_ - IT_OUT, lane); } \
        else if (r_ < IT_UP) { r_ -= IT_POOL; const int gi_ = r_ / I_POOL; transpose_item<0>(kp->pool_w + (size_t)gi_ * 65536, 256, 256, Wpool_t + (size_t)gi_ * 65536, scr, r_ % I_POOL, lane); } \
        else if (r_ < IT_DN) { r_ -= IT_UP; const int l_ = r_ / I_UP; transpose_item_up(kp->w_up + (size_t)l_ * DM * NUP, Wup_t + (size_t)l_ * 2 * NUP * DM, kp->ffn_norm + l_ * DM, \
                modf + (size_t)(l_ * 3) * NMOD + 4 * DM, modf + (size_t)(l_ * 3 + 1) * NMOD + 4 * DM, scr, r_ % I_UP, lane); } \
        else { r_ -= IT_DN; const int l_ = r_ / I_DN; transpose_item<0>(kp->w_down + (size_t)l_ * DFF * DM, DFF, DM, Wdn_t + (size_t)l_ * DM * DFF, scr, r_ % I_DN, lane); } } while (0)
#define BIAS_UP_CHUNK(l_, chunk_) do { LAS float* vecs_ = (LAS float*)lds; LAS float* red_ = (LAS float*)(lds + 16384); const int col0_ = (chunk_) * 64; \
        { float tv_[4]; _Pragma("unroll") for (int q_ = 0; q_ < 4; ++q_) { const int i_ = tid + q_ * NTHREADS, v_ = i_ >> 10, k_ = i_ & 1023; tv_[q_] = modf[((l_) * 3 + v_) * NMOD + 3 * DM + k_]; } \
          asm volatile("" ::: "memory"); _Pragma("unroll") for (int q_ = 0; q_ < 4; ++q_) vecs_[tid + q_ * NTHREADS] = tv_[q_]; } \
        LDS_WAIT(); __syncthreads(); \
        const float r_ = gemv64<2>(kp->w_up + (size_t)(l_) * DM * NUP, NUP, col0_, vecs_, red_, tid); \
        if (tid < 128) bias_up[((l_) * 2 + (tid >> 6)) * NUP + map_up(col0_ + (tid & 63))] = r_; \
        __syncthreads(); } while (0)
    for (int pi = lo; pi < hi; ++pi) {
        const int pe = args.prog[pi], ph = pe & 255; const bool probe = (pe & 256) != 0; (void)probe;
        int tid = TID_NOW(); asm volatile("" : "+v"(tid));
        const KArgs* kp = (const KArgs*)__builtin_amdgcn_kernarg_segment_ptr(); asm volatile("" : "+s"(kp));
        unsigned char* ws = kp->ws;
#define LANE_VARS const int lane = tid & 63, wave = __builtin_amdgcn_readfirstlane(tid >> 6); const int gw = vcu * NWAVES + wave, NGW = G * NWAVES; (void)lane; (void)gw; (void)NGW;
        float* modf = (float*)(ws + WS_MODF);
        f32x2* tab = (f32x2*)(ws + WS_TAB);
        float* bias_in = (float*)(ws + WS_BIN);
        float* bias_up = (float*)(ws + WS_BUP);
        float* gperm = (float*)(ws + WS_GP);
        float* rstd0 = (float*)(ws + WS_RSTD0);
        float* halo = (float*)(ws + WS_HALO);
        bf16_t* Win_t = (bf16_t*)(ws + WS_WIN); bf16_t* Wout_t = (bf16_t*)(ws + WS_WOUT); bf16_t* Wpool_t = (bf16_t*)(ws + WS_WPOOL);
        bf16_t* Wup_t = (bf16_t*)(ws + WS_WUP); bf16_t* Wdn_t = (bf16_t*)(ws + WS_WDN);
        bf16_t* XB = (bf16_t*)(ws + WS_XB); bf16_t* Qb = (bf16_t*)(ws + WS_Q); bf16_t* KA = (bf16_t*)(ws + WS_KA); bf16_t* VA = (bf16_t*)(ws + WS_VA);
        bf16_t* BU = (bf16_t*)(ws + WS_BU); bf16_t* CC = (bf16_t*)(ws + WS_CC); bf16_t* Hb = (bf16_t*)(ws + WS_H); bf16_t* PL = (bf16_t*)(ws + WS_PL);
        if (PHM(0) && ph == PH_MOD) {
            LANE_VARS
            const int vs = (G == 256) ? ((vcu & 31) < 24 ? (vcu >> 5) * 24 + (vcu & 31) : 192 + (vcu >> 5) * 8 + ((vcu & 31) - 24)) : vcu;
            LAS float* vecs = (LAS float*)lds; LAS float* red = (LAS float*)(lds + 16384);
            { float tv[6];
#pragma unroll
              for (int q = 0; q < 6; ++q) { const int i = tid + q * NTHREADS, v = i >> 10, k = i & 1023; tv[q] = v < 2 ? kp->c[v * 1024 + k] : kp->c_ctx[k]; }
              asm volatile("" ::: "memory");
#pragma unroll
              for (int q = 0; q < 6; ++q) vecs[tid + q * NTHREADS] = silu_f(tv[q]); }
            LDS_WAIT(); __syncthreads();
            if (!(pe & 2048)) for (int chunk = vs; chunk < 2 * 96; chunk += G) { const int l = chunk / 96, col0 = (chunk % 96) * 64;
                const float r = gemv64<3>(kp->ada_w + (size_t)l * DM * NMOD, NMOD, col0, vecs, red, tid);
                if (tid < 192) modf[(l * 3 + (tid >> 6)) * NMOD + col0 + (tid & 63)] = r + kp->ada_b[l * NMOD + col0 + (tid & 63)]; }
            __syncthreads();
            const bool split0 = G > 192 + 32;
            if (!split0 || vs >= 192) {
                const int gwx = split0 ? (vs - 192) * NWAVES + wave : gw, ngwx = split0 ? (G - 192) * NWAVES : NGW;
                for (int i = gwx * 64 + lane; i < 192 * 32 + 256; i += ngwx * 64) {
                if (i < 192 * 32) { const int pos = (i >> 5) < 128 ? (i >> 5) : (i >> 5) - 128, f = i & 31;
                    const float inv = powf(10000.0f, -(float)(2 * f) / 64.0f); const float ang = (float)pos * inv;
                    tab[i] = (f32x2){cosf(ang), sinf(ang)};
                } else { const int j = i - 192 * 32, hq = j >> 7, dp = j & 127, p = dp >> 1, hf = dp & 1, a = p >> 5, fi = p & 31, d = a * 64 + hf * 32 + fi;
                    gperm[j] = hq == 0 ? kp->q_gain[d] : kp->k_gain[d]; }
                }
            }
            {
                constexpr int NITEM = MALL / 4;
                const int nlo = 192 * NWAVES, nhi_items = NITEM - nlo;
                int it0, itn, its;
                if (split0 && G == 256) { if (vs >= 192) { it0 = (vs - 192) * NWAVES + wave; itn = nhi_items; its = 64 * NWAVES; } else { it0 = nhi_items + vs * NWAVES + wave; itn = NITEM; its = nlo; } }
                else { it0 = gw; itn = NITEM; its = NGW; }
#define XP_LOAD(buf, item) do { const int r0_ = (item) * 4; const float* src_ = r0_ < MROWS ? kp->x + (size_t)r0_ * DM : kp->ctx + (size_t)(r0_ - MROWS) * DM; \
                    _Pragma("unroll") for (int q = 0; q < 4; ++q) _Pragma("unroll") for (int j = 0; j < 4; ++j) buf[q][j] = __builtin_nontemporal_load((const f32x4*)(src_ + (size_t)q * DM + 256 * j + 4 * lane)); } while (0)
#define XP_DONE(buf, item) do { const int r0_ = (item) * 4; float sq[4]; \
                    _Pragma("unroll") for (int q = 0; q < 4; ++q) { float s_ = 0.f; \
                        _Pragma("unroll") for (int j = 0; j < 4; ++j) s_ += (buf[q][j][0] * buf[q][j][0] + buf[q][j][1] * buf[q][j][1]) + (buf[q][j][2] * buf[q][j][2] + buf[q][j][3] * buf[q][j][3]); \
                        sq[q] = wave_sum(s_); } \
                    if (lane < 4) rstd0[r0_ + lane] = __builtin_amdgcn_rsqf((lane == 0 ? sq[0] : lane == 1 ? sq[1] : lane == 2 ? sq[2] : sq[3]) * (1.0f / DM) + EPS); \
                    _Pragma("unroll") for (int q = 0; q < 4; ++q) _Pragma("unroll") for (int j = 0; j < 4; ++j) { const int c = 256 * j + 4 * lane; const f32x4 z = buf[q][j]; \
                        u32x2 w; w.x = cvtpk(z[0], z[1]); w.y = cvtpk(z[2], z[3]); *(u32x2*)(XB + (size_t)(r0_ + q) * DM + c) = w; } } while (0)
                if (!(pe & 1024)) for (int r4 = it0; r4 < itn; r4 += 2 * its) {
                    f32x4 xa[4][4], xb2[4][4];
                    const bool hasb = r4 + its < itn; const int r4b = hasb ? r4 + its : r4;
                    XP_LOAD(xa, r4);
                    XP_LOAD(xb2, r4b);
                    asm volatile("" ::: "memory");
                    XP_DONE(xa, r4);
                    if (hasb) XP_DONE(xb2, r4b);
                }
#undef XP_LOAD
#undef XP_DONE
            }
        } else if (PHM(1) && ph == PH_PREP) {
            LANE_VARS
            const int vp = (G == 256) ? ((vcu & 31) < 5 ? (vcu >> 5) * 5 + (vcu & 31) : 40 + (vcu >> 5) * 27 + ((vcu & 31) - 5)) : vcu;
            {
                LAS float* vecs = (LAS float*)lds; LAS float* red = (LAS float*)(lds + 16384);
                for (int chunk = vp; chunk < 40; chunk += G) {
                    __syncthreads();
                    { float tv[6];
#pragma unroll
                      for (int q = 0; q < 6; ++q) { const int i = tid + q * NTHREADS, v = i >> 10, k = i & 1023; tv[q] = modf[(0 * 3 + v) * NMOD + k]; }
                      asm volatile("" ::: "memory");
#pragma unroll
                      for (int q = 0; q < 6; ++q) vecs[tid + q * NTHREADS] = tv[q]; }
                    LDS_WAIT(); __syncthreads();
                    const int col0 = chunk * 64;
                    const float r = gemv64<3>(kp->w_in, NIN, col0, vecs, red, tid);
                    if (tid < 192) bias_in[(tid >> 6) * NIN + map_in(col0 + (tid & 63))] = r;
                }
                __syncthreads();
            }
            const bool split1 = G > 40 + 64;
            const int gwy = split1 ? (vp - 40) * NWAVES + wave : gw, ngwy = split1 ? (G - 40) * NWAVES : NGW;
            if (!split1 || vp >= 40) {
                LAS float* scr = (LAS float*)(lds + wave * 16384);
                for (int it = gwy; it < I_IN; it += ngwy) { TRANSPOSE_IT(it); }
            }
        } else if (PHM(2) && ph == PH_INPROJ) {
            pg8::Gemm g{XB, DM, 0, Win_t, DM, DM, (size_t)NIN * DM * 2};
            pg8::InProjOrder S; S.init(G, bid);
            pg8::EpiInProj E{ws};
            pg8::gemm_phase(lds, xlds, g, S, E, tid);
            if (G == 256 && bid >= 132) {
                LANE_VARS
                const int share = bid - 132, nshare = 124;
                if (share < 88) BIAS_UP_CHUNK(0, share);
                LAS float* scr = (LAS float*)(lds + wave * 16384);
                for (int j = share * NWAVES + wave; j < I_OUT + I_UP; j += nshare * NWAVES) { const int it = j < I_OUT ? IT_OUT + j : IT_UP + (j - I_OUT); TRANSPOSE_IT(it); }
            } else if (G != 256) {
                LANE_VARS
                for (int ch = vcu; ch < 88; ch += G) BIAS_UP_CHUNK(0, ch);
                LAS float* scr = (LAS float*)(lds + wave * 16384);
                for (int j = gw; j < I_OUT + I_UP; j += NGW) { const int it = j < I_OUT ? IT_OUT + j : IT_UP + (j - I_OUT); TRANSPOSE_IT(it); }
            }
        } else if (PHM(3) && ph == PH_ATTN) {
            LANE_VARS
            for (int r8 = gw; r8 < MROWS / 8; r8 += NGW) {
                const int r0 = r8 * 8, c = lane * 8;
                f32x4 k0a = *(const f32x4*)(kp->conv_w + c), k0b = *(const f32x4*)(kp->conv_w + c + 4);
                f32x4 k1a = *(const f32x4*)(kp->conv_w + 512 + c), k1b = *(const f32x4*)(kp->conv_w + 512 + c + 4);
                f32x4 k2a = *(const f32x4*)(kp->conv_w + 1024 + c), k2b = *(const f32x4*)(kp->conv_w + 1024 + c + 4);
                const float kw0[8] = {k0a[0], k0a[1], k0a[2], k0a[3], k0b[0], k0b[1], k0b[2], k0b[3]};
                const float kw1[8] = {k1a[0], k1a[1], k1a[2], k1a[3], k1b[0], k1b[1], k1b[2], k1b[3]};
                const float kw2[8] = {k2a[0], k2a[1], k2a[2], k2a[3], k2b[0], k2b[1], k2b[2], k2b[3]};
                u32x4 uu[10], bbv[8];
#pragma unroll
                for (int i = 0; i < 10; ++i) { const int r = r0 - 1 + i;
                    const bool inb = (i == 0) ? ((r0 & (SEQ - 1)) != 0) : ((i == 9) ? (((r0 + 8) & (SEQ - 1)) != 0) : true);
                    const int rc = inb ? r : r0;
                    const u32x4 ld = __builtin_nontemporal_load((const u32x4*)(BU + (size_t)rc * DM + 512 + c));
                    uu[i] = inb ? ld : (u32x4){0u, 0u, 0u, 0u}; }
#pragma unroll
                for (int i = 0; i < 8; ++i) bbv[i] = __builtin_nontemporal_load((const u32x4*)(BU + (size_t)(r0 + i) * DM + c));
#pragma unroll
                for (int i = 0; i < 8; ++i) { const u32x4 up = uu[i], cu = uu[i + 1], dn = uu[i + 2], bb = bbv[i];
                    u32x4 o;
#pragma unroll
                    for (int q = 0; q < 4; ++q) {
                        const float y0 = bflo(bb[q]) * (kw0[2 * q] * bflo(up[q]) + kw1[2 * q] * bflo(cu[q]) + kw2[2 * q] * bflo(dn[q]));
                        const float y1 = bfhi(bb[q]) * (kw0[2 * q + 1] * bfhi(up[q]) + kw1[2 * q + 1] * bfhi(cu[q]) + kw2[2 * q + 1] * bfhi(dn[q]));
                        o[q] = cvtpk(y0, y1); }
                    *(u32x4*)(CC + (size_t)(r0 + i) * DM + 512 + c) = o; }
            }
            __syncthreads();
            for (int unit = vcu; unit < 256; unit += G) {
                const int combo = unit >> 6, within = unit & 63, b = combo >> 1, kvh = combo & 1, h = kvh * 2 + (within >> 5), qb = within & 31;
                const size_t qrow = (size_t)b * SEQ + qb * 256;
                attn::attn_dense_body((const attn::bf16*)Qb + qrow * 512 + h * 128, (const attn::bf16*)KA + (size_t)b * SKV * 256 + kvh * 128,
                                      (const attn::bf16*)VA + (size_t)b * SKV * 256 + kvh * 128, (attn::bf16*)CC + qrow * DM + h * 128, SKV, (char*)lds_raw, tid);
                __syncthreads();
            }
        } else if (PHM(4) && (ph == PH_OUTPROJ || ph == PH_DOWN0 || ph == PH_POOLG || ph == PH_DOWN1)) {
            const int k = ph == PH_OUTPROJ ? 0 : (ph == PH_DOWN0 ? 1 : (ph == PH_POOLG ? 2 : 3));
            const size_t a_off = k == 0 ? WS_CC : (k == 2 ? WS_PL : WS_H);
            const size_t b_off = k == 0 ? WS_WOUT : (k == 1 ? WS_WDN : (k == 2 ? WS_WPOOL : WS_WDN + (size_t)DM * DFF * 2));
            const int lda = (k == 0 || k == 2) ? DM : DFF, ldb = k == 0 ? DM : (k == 2 ? 256 : DFF), acol = k == 2 ? 256 : 0;
            pg8::Gemm g{(const bf16_t*)(ws + a_off), lda, acol, (const bf16_t*)(ws + b_off), ldb, ldb, 0};
            pg8::EpiResid E{ws, kp, k, probe ? 1 : 0};
            pg8::StaticOrder S; S.init(MROWS, DM, G, bid);
            { pg8::Unit u0; if (S.next(0, u0)) {
                const int pm = u0.pm;
                if (k == 1 || k == 3) {
                    const float* cw = kp->fconv_w + (size_t)(k == 3 ? 1 : 0) * 3 * DFF;
                    constexpr int NIT = (DFF + NTHREADS - 1) / NTHREADS;
                    f32x2 P[NIT], val[NIT], nb[NIT], wv[NIT];
#pragma unroll
                    for (int q = 0; q < NIT; ++q) { const int i_ = tid + q * NTHREADS, i = i_ < DFF ? i_ : DFF - 1;
                        const int edge = i >= DFF / 2 ? 1 : 0, ch = 2 * (i - edge * (DFF / 2)), pn_ = ch >> 7, cc = ch & 127;
                        const float* hp = halo + ((size_t)(pm * 22 + pn_) * 6 + edge * 3) * 128 + cc;
                        P[q] = *(const f32x2*)hp; val[q] = *(const f32x2*)(hp + 128);
                        const bool nbv = edge == 0 ? ((pm & 31) != 0) : ((pm & 31) != 31);
                        const int pmn = nbv ? (edge == 0 ? pm - 1 : pm + 1) : pm;
                        const f32x2 nbl = *(const f32x2*)(halo + ((size_t)(pmn * 22 + pn_) * 6 + (edge == 0 ? 5 : 2)) * 128 + cc);
                        nb[q] = nbv ? nbl : (f32x2){0.f, 0.f};
                        wv[q] = *(const f32x2*)(cw + (edge == 0 ? 0 : 2) * DFF + ch); }
#pragma unroll
                    for (int q = 0; q < NIT; ++q) { const int i = tid + q * NTHREADS;
                        if (i < DFF) { const int edge = i >= DFF / 2 ? 1 : 0, ch = 2 * (i - edge * (DFF / 2));
                            const float h0 = silu_f(P[q].x + wv[q].x * nb[q].x) * val[q].x, h1 = silu_f(P[q].y + wv[q].y * nb[q].y) * val[q].y;
                            *(unsigned*)(Hb + ((size_t)pm * 256 + (edge ? 255 : 0)) * DFF + ch) = cvtpk(h0, h1); } }
                } else if (k == 2) {
                    LANE_VARS
                    const bf16_t* xr = (const bf16_t*)(ws + WS_XB); const float* ssq = (const float*)(ws + WS_SSQ + SSQ_BYTES);
                    const int b = pm >> 5, gi = u0.pn, t0 = (pm & 31) * 256 + wave * 32, c = gi * 256 + lane * 4;
                    const f32x4 nv = *(const f32x4*)(kp->mix_norm + DM + c) * (1.0f + *(const f32x4*)(modf + (3 + b) * NMOD + DM + c));
                    float rs_l = 0.f;
                    { const int t = t0 - 8 + lane; if (lane < 48 && t >= 0 && t < SEQ) { const f32x4* sp = (const f32x4*)(ssq + ((size_t)b * SEQ + t) * 16); const f32x4 s0 = sp[0], s1 = sp[1], s2 = sp[2], s3 = sp[3];
                        const float tot = ((s0[0] + s0[1]) + (s0[2] + s0[3])) + ((s1[0] + s1[1]) + (s1[2] + s1[3])) + ((s2[0] + s2[1]) + (s2[2] + s2[3])) + ((s3[0] + s3[1]) + (s3[2] + s3[3]));
                        rs_l = __builtin_amdgcn_rsqf(tot * (1.0f / DM) + EPS); } }
                    const bf16_t* xb = xr + (size_t)b * SEQ * DM + c;
                    const int tile0 = (pm & 31) * 256;
                    const int pmp = tile0 > 0 ? pm - 1 : pm, pmn = tile0 < SEQ - 256 ? pm + 1 : pm;
                    const bf16_t* xe_prev = (const bf16_t*)(ws + WS_XE) + (size_t)(pmp * 4 + gi) * 16 * 256 + lane * 4;
                    const bf16_t* xe_next = (const bf16_t*)(ws + WS_XE) + (size_t)(pmn * 4 + gi) * 16 * 256 + lane * 4;
                    bf16_t* dst = PL + (size_t)b * SEQ * DM + c;
                    if (gi == 0) pool_rows32<1>(xb, xe_prev, xe_next, tile0, t0, rs_l, nv, dst);
                    else if (gi == 1) pool_rows32<2>(xb, xe_prev, xe_next, tile0, t0, rs_l, nv, dst);
                    else if (gi == 2) pool_rows32<4>(xb, xe_prev, xe_next, tile0, t0, rs_l, nv, dst);
                    else pool_rows32<8>(xb, xe_prev, xe_next, tile0, t0, rs_l, nv, dst);
                }
                VM_WAIT(); __syncthreads();
            } }
            pg8::gemm_phase(lds, xlds, g, S, E, tid);
        } else if (PHM(5) && (ph == PH_UP0 || ph == PH_UP1)) {
            const int l = ph == PH_UP0 ? 0 : 1;
            pg8::Gemm g{(const bf16_t*)(ws + WS_XB), DM, 0, Wup_t + (size_t)l * 2 * NUP * DM, DM, DM, (size_t)NUP * DM * 2};
            pg8::EpiFfnUp E{ws, kp, l, (pe & 512) ? 1 : 0};
            pg8::StaticOrder S; S.init(MROWS, NUP, G, bid);
            if (tid == 0) *(volatile LAS int*)(xlds + 4096 + 1024) = -1;
            LDS_WAIT(); __syncthreads();
#if defined(PROBE_PHASE)
            pg8::gemm_phase(lds, xlds, g, S, E, tid, (pe >> 12) & 3);
#else
            pg8::gemm_phase(lds, xlds, g, S, E, tid);
#endif
            if (l == 0) {
                const bool std_grid = (G == 256);
                if (!std_grid || bid >= 128) {
                    LANE_VARS
                    const int share = std_grid ? bid - 128 : vcu, nshare = std_grid ? 128 : G;
                    for (int ch = share; ch < 88; ch += nshare) BIAS_UP_CHUNK(1, ch);
                    LAS float* scr = (LAS float*)(lds + wave * 16384);
                    constexpr int NJ = 4 * I_POOL + I_UP + I_DN;
                    for (int j = share * NWAVES + wave; j < NJ; j += nshare * NWAVES) {
                        const int it = j < 4 * I_POOL ? IT_POOL + j : (j < 4 * I_POOL + I_UP ? IT_UP + I_UP + (j - 4 * I_POOL) : IT_DN + (j - 4 * I_POOL - I_UP));
                        TRANSPOSE_IT(it); }
                }
            } else {
                const bool std_grid = (G == 256);
                if (!std_grid || bid >= 128) {
                    LANE_VARS
                    const int share = std_grid ? bid - 128 : vcu, nshare = std_grid ? 128 : G;
                    LAS float* scr = (LAS float*)(lds + wave * 16384);
                    for (int j = share * NWAVES + wave; j < I_DN; j += nshare * NWAVES) { const int it = IT_DN + I_DN + j; TRANSPOSE_IT(it); }
                }
            }
        }
        if (use_bar && pi + 1 < hi) xcd_barrier(bar, TID_NOW() == 0);
    }
}


extern "C" void kernel_launch(void* const* d_in, const int* in_sizes, int n_in, void* d_out, int out_size, void* d_ws, size_t ws_size, hipStream_t stream) {
    static int grid = 0;
    if (grid == 0) {
        if (n_in != 19 || in_sizes[0] != MROWS * DM || out_size != MROWS * DM || ws_size < WS_TOP) {
            fprintf(stderr, "kernel_launch: unexpected shapes: n_in %d in0 %d out %d ws %zu (need %zu)\n", n_in, n_in > 0 ? in_sizes[0] : -1, out_size, ws_size, (size_t)WS_TOP); grid = -1; return; }
        int dev = 0, cus = 0;
        if (hipGetDevice(&dev) != hipSuccess || hipDeviceGetAttribute(&cus, hipDeviceAttributeMultiprocessorCount, dev) != hipSuccess) { grid = -1; return; }
        int per_cu = 0;
        if (hipOccupancyMaxActiveBlocksPerMultiprocessor(&per_cu, (const void*)fwd_kernel, NTHREADS, 0) != hipSuccess || per_cu < 1) fprintf(stderr, "kernel_launch: occupancy query says %d\n", per_cu);
        (void)hipGetLastError();
        grid = cus;
    }
    if (grid < 0) return;
    (void)hipMemsetAsync((char*)d_ws + WS_CTL, 0, CTL_BYTES, stream);
    Args a{};
    const float** ap = (const float**)&a;
    for (int i = 0; i < 19; ++i) ap[i] = (const float*)d_in[i];
    a.out = (float*)d_out; a.ws = (unsigned char*)d_ws; a.grid = grid;
    constexpr int NL = MK_N_LAUNCHES;
    int np = 0;
    for (int p = 0; p < (int)PH_COUNT; ++p) {
#if defined(PROBE_PHASE)
        if (p == PROBE_PHASE) a.prog[np++] = p | 256 | PROBE_FLAGS;
#endif
        a.prog[np++] = p;
    }
    for (int li = 0; li < NL; ++li) {
        a.ph_lo = (NL == 1) ? 0 : li; a.ph_hi = (NL == 1) ? np : li + 1;
        hipLaunchKernelGGL(fwd_kernel, dim3(grid), dim3(NTHREADS), 0, stream, a);
        const hipError_t le = hipPeekAtLastError();
        if (le != hipSuccess) { fprintf(stderr, "kernel_launch: launch %d failed: %s\n", li, hipGetErrorName(le)); break; }
    }
}
```

```cpp
#include <hip/hip_runtime.h>
#include <hip/hip_bf16.h>
#include <cstdio>
#include <cstdint>
#include <type_traits>

#ifndef MK_N_LAUNCHES
#define MK_N_LAUNCHES 1
#endif

#ifndef DBG_MAXPH
#define DBG_MAXPH 13
#ifndef PROBE_FLAGS
#define PROBE_FLAGS 0
#endif
#endif
#define LAS __attribute__((address_space(3)))
#define GAS __attribute__((address_space(1)))
typedef unsigned short bf16_t;
typedef short bf16x8 __attribute__((ext_vector_type(8)));
typedef float f32x4 __attribute__((ext_vector_type(4)));
typedef float f32x2 __attribute__((ext_vector_type(2)));
typedef unsigned u32x4 __attribute__((ext_vector_type(4)));
typedef unsigned u32x2 __attribute__((ext_vector_type(2)));
typedef __bf16 bf16x2_t __attribute__((ext_vector_type(2)));

constexpr int DM = 1024, SEQ = 8192, NB = 2, MROWS = NB * SEQ, CTXL = 256, MCTX = NB * CTXL, MALL = MROWS + MCTX;
constexpr int NIN = 2560, DFF = 2816, NUP = 2 * DFF, SKV = CTXL + SEQ;
constexpr int NMOD = 6 * DM;
constexpr float EPS = 1e-6f;
constexpr int NTHREADS = 512, NWAVES = 8;

constexpr size_t al256(size_t x) { return (x + 255) & ~(size_t)255; }
constexpr size_t WS_CTL = 0, CTL_BYTES = 1u << 20;
constexpr size_t WS_MODF = CTL_BYTES;
constexpr size_t WS_TAB = WS_MODF + al256((size_t)2 * 3 * NMOD * 4);
constexpr size_t WS_BIN = WS_TAB + al256((size_t)192 * 32 * 8);
constexpr size_t WS_BUP = WS_BIN + al256((size_t)3 * NIN * 4);
constexpr size_t WS_GP = WS_BUP + al256((size_t)4 * NUP * 4);
constexpr size_t WS_RSTD0 = WS_GP + al256(256 * 4);
constexpr size_t WS_SSQ = WS_RSTD0 + al256((size_t)MALL * 4);
constexpr size_t SSQ_BYTES = al256((size_t)MROWS * 16 * 4);
constexpr size_t WS_HALO = WS_SSQ + 3 * SSQ_BYTES;
constexpr size_t WS_WIN = WS_HALO + al256((size_t)64 * 22 * 6 * 128 * 4);
constexpr size_t WS_WOUT = WS_WIN + al256((size_t)3 * NIN * DM * 2);
constexpr size_t WS_WPOOL = WS_WOUT + al256((size_t)DM * DM * 2);
constexpr size_t WS_WUP = WS_WPOOL + al256((size_t)4 * 256 * 256 * 2);
constexpr size_t WS_WDN = WS_WUP + al256((size_t)4 * NUP * DM * 2);
constexpr size_t WS_XB = WS_WDN + al256((size_t)2 * DM * DFF * 2);
constexpr size_t WS_R2 = WS_XB + al256((size_t)MALL * DM * 2);
constexpr size_t WS_Q = WS_R2;
constexpr size_t WS_KA = WS_Q + al256((size_t)MROWS * 512 * 2);
constexpr size_t WS_VA = WS_KA + al256((size_t)NB * SKV * 256 * 2);
constexpr size_t WS_BU = WS_VA + al256((size_t)NB * SKV * 256 * 2);
constexpr size_t WS_CC = WS_BU + al256((size_t)MROWS * DM * 2);
constexpr size_t WS_END = WS_CC + al256((size_t)MROWS * DM * 2);
constexpr size_t WS_H = WS_R2;
constexpr size_t WS_PL = WS_R2;
static_assert(WS_H + (size_t)MROWS * DFF * 2 <= WS_END, "H overlay");
constexpr size_t WS_XE = WS_END;
constexpr size_t WS_TOP = WS_XE + (size_t)64 * 4 * 16 * 256 * 4;
static_assert(WS_TOP <= (size_t)256 * 1024 * 1024, "workspace");

constexpr int RING_BYTES = 131072;
constexpr int XCH_OFF = RING_BYTES;
constexpr int MISC_OFF = XCH_OFF + 16384;
constexpr int LDS_BYTES = MISC_OFF + 256;

__device__ __forceinline__ unsigned cvtpk(float lo, float hi) { f32x2 v = {lo, hi}; bf16x2_t b = __builtin_convertvector(v, bf16x2_t); return __builtin_bit_cast(unsigned, b); }
__device__ __forceinline__ void st16_wt(void* p, u32x4 w) { asm volatile("global_store_dwordx4 %0, %1, off sc1\n\ts_nop 1" :: "v"(p), "v"(w) : "memory"); }
__device__ __forceinline__ void st8_wt(void* p, u32x2 w) { asm volatile("global_store_dwordx2 %0, %1, off sc1\n\ts_nop 1" :: "v"(p), "v"(w) : "memory"); }
__device__ __forceinline__ float bflo(unsigned w) { return __uint_as_float(w << 16); }
__device__ __forceinline__ float bfhi(unsigned w) { return __uint_as_float(w & 0xffff0000u); }
__device__ __forceinline__ float silu_f(float x) { return x * __builtin_amdgcn_rcpf(1.0f + __builtin_amdgcn_exp2f(-1.4426950408889634f * x)); }
__device__ __forceinline__ float wave_sum(float v) {
#pragma unroll
    for (int o = 1; o < 64; o <<= 1) v += __shfl_xor(v, o);
    return v;
}
#define LDS_WAIT() asm volatile("s_waitcnt lgkmcnt(0)" ::: "memory")
#define VM_WAIT() asm volatile("s_waitcnt vmcnt(0)" ::: "memory")
#define RLX_AGENT __ATOMIC_RELAXED, __HIP_MEMORY_SCOPE_AGENT

__device__ __forceinline__ int map_in(int o) {
    if (o < 768) { const int base = o & ~127, d = o & 127, a = d >> 6, hf = (d >> 5) & 1, i = d & 31; return base + 2 * (a * 32 + i) + hf; }
    if (o < 1536) return o;
    const int s = (o >= 2048) ? 1 : 0, ch = o - (s ? 2048 : 1536); return 1536 + 256 * (ch >> 7) + 128 * s + (ch & 127);
}
__device__ __forceinline__ int map_up(int o) { const int s = (o >= DFF) ? 1 : 0, ch = o - s * DFF; return 256 * (ch >> 7) + 128 * s + (ch & 127); }

struct Args {
    const float *x, *c, *ctx, *c_ctx, *ada_w, *ada_b, *mix_norm, *ffn_norm, *w_in, *q_gain, *k_gain, *conv_w, *w_out, *pool_w, *pool_scale, *w_up, *fconv_w, *fconv_b, *w_down;
    float* out; unsigned char* ws; int ph_lo, ph_hi, grid, pad;
    int prog[16];
};
typedef const Args __attribute__((address_space(4))) KArgs;

namespace pg8 {
constexpr int BM = 256, BK = 64, HALF = 128, HTB = HALF * BK * 2, NXCD = 8, WGM = 8;
__host__ __device__ __forceinline__ int lds_byte(int r, int c) { const int st = (r >> 4) * 2 + (c >> 5), rr = r & 15, cc = c & 31, ob = rr * 64 + cc * 2; return st * 1024 + (ob ^ (((ob >> 9) & 1) << 5)); }
__host__ __device__ __forceinline__ void stage_rc(int b, int& R, int& C) { const int st = b / 1024, sb = b % 1024, swz = sb ^ (((sb >> 9) & 1) << 5); R = (st >> 1) * 16 + swz / 64; C = (st & 1) * 32 + (swz % 64) / 2; }
__host__ __device__ __forceinline__ int perm32(int rho) { const int n = rho >> 4, i = rho & 15; return 8 * (i >> 2) + 4 * n + (i & 3); }

struct Unit { int pm, pn; };
struct Gemm { const bf16_t* A; int lda; int acol; const bf16_t* Bt; int ldb; int K; size_t bbatch; };

struct StaticOrder {
    int nM, nN, nwg, G, c;
    __device__ void init(int M, int N, int G_, int c_) { nM = M / BM; nN = N / BM; nwg = nM * nN; G = G_; c = c_; }
    __device__ __forceinline__ void tile(int L, Unit& u) const {
        int wgid = L; { const int q = nwg / NXCD, r = nwg % NXCD, xcd = wgid % NXCD, off = wgid / NXCD; wgid = (xcd < r ? xcd * (q + 1) : r * (q + 1) + (xcd - r) * q) + off; }
        const int nig = WGM * nN, gid = wgid / nig, fm = gid * WGM, gsz = (nM - fm) < WGM ? (nM - fm) : WGM;
        u.pm = fm + ((wgid % nig) % gsz); u.pn = (wgid % nig) / gsz;
    }
    __device__ __forceinline__ bool next(int i, Unit& u) const { const long L = (long)i * G + c; if (L >= nwg) return false; tile((int)L, u); return true; }
};
struct InProjOrder {
    StaticOrder so;
    __device__ void init(int G_, int c_) { so.init(MROWS, NIN, G_, c_); }
    __device__ __forceinline__ bool next(int i, Unit& u) const {
        const long L = (long)i * so.G + so.c; if (L >= so.nwg + 4) return false;
        if (L < so.nwg) { so.tile((int)L, u); return true; }
        const int k = (int)L - so.nwg; u.pm = 64 + (k >> 1); u.pn = 2 + (k & 1); return true;
    }
};

template <class Epi, class Sched>
__device__ __forceinline__ void gemm_phase(LAS unsigned char* lds, LAS unsigned char* xlds, const Gemm g, const Sched& S, const Epi& E, const int tid, const int pmode = 0) {
    const int wid = __builtin_amdgcn_readfirstlane(tid >> 6), lane = tid & 63, wr = wid >> 2, wc = wid & 3, fr = lane & 15, fq = lane >> 4;
    const int K = g.K, nt = K / BK;
    unsigned voffA, voffB;
    { int R, C; stage_rc(tid * 16, R, C); const int Rb = Epi::PERM ? ((R & ~31) + perm32(R & 31)) : R;
      voffA = (unsigned)(R * g.lda + C) * 2u; voffB = (unsigned)(Rb * g.ldb + C) * 2u; }
    const size_t p2A = (size_t)64 * g.lda * 2, p2B = (size_t)64 * g.ldb * 2;
    const size_t kstep = (size_t)(BK * 2);
    const size_t hstepA = (size_t)HALF * g.lda * 2, hstepB = (size_t)HALF * g.ldb * 2;
    const unsigned ldsw = (unsigned)wid * 1024u;
    int aoff = lds_byte(wr * 64 + fr, fq * 8), boff = lds_byte(wc * 32 + fr, fq * 8) + 4 * HTB; asm volatile("" : "+v"(aoff), "+v"(boff));
#define PG8_SA(b, h) (((b) * 2 + (h)) * HTB)
#define PG8_SB(b, h) ((4 + (b) * 2 + (h)) * HTB)
#define PG8_STAGE_(bufoff, gbase, vo, p2) do { if (!(pmode & 2)) _Pragma("unroll") for (int _i = 0; _i < 2; ++_i) \
        __builtin_amdgcn_global_load_lds((const unsigned*)((const char*)(gbase) + (size_t)_i * (p2) + (vo)), (LAS unsigned*)(lds + (bufoff) + ldsw + _i * 8192), 16, 0, 0); } while (0)
#define PG8_STAGE(bufoff, gbase, which) PG8_STAGE_##which(bufoff, gbase)
#define PG8_STAGE_offA(bufoff, gbase) PG8_STAGE_(bufoff, gbase, voffA, p2A)
#define PG8_STAGE_offB(bufoff, gbase) PG8_STAGE_(bufoff, gbase, voffB, p2B)
#define PG8_LDA(dst, b, h) do { _Pragma("unroll") for (int m = 0; m < 4; ++m) _Pragma("unroll") for (int k = 0; k < 2; ++k) dst[m][k] = *(const LAS bf16x8*)(lds + aoff + (PG8_SA(b, h) + m * 2048 + k * 1024)); } while (0)
#define PG8_LDB(dst, b, h) do { _Pragma("unroll") for (int n = 0; n < 2; ++n) _Pragma("unroll") for (int k = 0; k < 2; ++k) dst[n][k] = *(const LAS bf16x8*)(lds + boff + (((b) * 2 + (h)) * HTB + n * 2048 + k * 1024)); } while (0)
#define PG8_MMA(ai, bj, At, Bt) do { __builtin_amdgcn_s_setprio(1); if (!(pmode & 1)) _Pragma("unroll") for (int m = 0; m < 4; ++m) _Pragma("unroll") for (int n = 0; n < 2; ++n) _Pragma("unroll") for (int k = 0; k < 2; ++k) \
        acc[ai][bj][m][n] = __builtin_amdgcn_mfma_f32_16x16x32_bf16(Bt[n][k], At[m][k], acc[ai][bj][m][n], 0, 0, 0); __builtin_amdgcn_s_setprio(0); } while (0)
#define PG8_WAIT_V(n) asm volatile("s_waitcnt vmcnt(" #n ")" ::: "memory")
#define PG8_WAIT_L(n) asm volatile("s_waitcnt lgkmcnt(" #n ")" ::: "memory")
#define PG8_BAR __builtin_amdgcn_s_barrier()
#define PG8_SCHED __builtin_amdgcn_sched_barrier(0)
#define PG8_UA(u) ((const char*)g.A + ((size_t)(u).pm * BM * g.lda + (size_t)(u).pn * g.acol) * 2)
#define PG8_UB(u) ((const char*)g.Bt + (size_t)(u).pn * BM * g.ldb * 2 + (size_t)((u).pm >= 64 ? 2 : ((u).pm >= 32 ? 1 : 0)) * g.bbatch)
    Unit cur, nxt; int ui = 0;
    if (!S.next(0, cur)) return;
    f32x4 acc[2][2][4][2];
#pragma unroll
    for (int a = 0; a < 2; ++a)
#pragma unroll
        for (int b = 0; b < 2; ++b)
#pragma unroll
            for (int m = 0; m < 4; ++m)
#pragma unroll
                for (int n = 0; n < 2; ++n) acc[a][b][m][n] = (f32x4){0.f, 0.f, 0.f, 0.f};
    bf16x8 At[4][2], B0[2][2], B1[2][2];
    const char* cA = PG8_UA(cur); const char* cB = PG8_UB(cur);
    PG8_STAGE(PG8_SB(0, 0), cB, offB); PG8_STAGE(PG8_SB(0, 1), cB + hstepB, offB); PG8_STAGE(PG8_SA(0, 0), cA, offA); PG8_STAGE(PG8_SA(0, 1), cA + hstepA, offA);
    if (wr == 1) PG8_BAR;
    PG8_WAIT_V(2); PG8_BAR;
    PG8_STAGE(PG8_SB(1, 0), cB + kstep, offB); PG8_STAGE(PG8_SA(1, 0), cA + kstep, offA); PG8_STAGE(PG8_SB(1, 1), cB + hstepB + kstep, offB);
    PG8_WAIT_V(6); PG8_BAR;
    for (;;) {
        const bool has_next = S.next(ui + 1, nxt);
        const char* nA = has_next ? PG8_UA(nxt) : cA; const char* nB = has_next ? PG8_UB(nxt) : cB;
        for (int t = 0; t < nt; t += 2) {
            const bool last = (t == nt - 2);
            const char* a1 = cA + (size_t)(t + 1) * kstep;
            const char* a2 = last ? nA : cA + (size_t)(t + 2) * kstep; const char* b2 = last ? nB : cB + (size_t)(t + 2) * kstep;
            const char* a3 = a2 + kstep; const char* b3 = b2 + kstep;
            PG8_LDB(B0, 0, 0); PG8_LDB(B1, 0, 1); PG8_SCHED; PG8_LDA(At, 0, 0); PG8_STAGE(PG8_SA(1, 1), a1 + hstepA, offA);
            PG8_WAIT_V(8); PG8_WAIT_L(0); PG8_BAR; PG8_MMA(0, 0, At, B0); PG8_MMA(0, 1, At, B1); PG8_BAR; PG8_SCHED;
            PG8_LDA(At, 0, 1); PG8_STAGE(PG8_SB(0, 0), b2, offB); PG8_STAGE(PG8_SB(0, 1), b2 + hstepB, offB); PG8_STAGE(PG8_SA(0, 0), a2, offA);
            PG8_WAIT_V(8); PG8_WAIT_L(0); PG8_BAR; PG8_MMA(1, 0, At, B0); PG8_MMA(1, 1, At, B1); PG8_BAR; PG8_SCHED;
            PG8_LDB(B0, 1, 0); PG8_LDB(B1, 1, 1); PG8_SCHED; PG8_LDA(At, 1, 0); PG8_STAGE(PG8_SA(0, 1), a2 + hstepA, offA);
            PG8_WAIT_V(8); PG8_WAIT_L(0); PG8_BAR; PG8_MMA(0, 0, At, B0); PG8_MMA(0, 1, At, B1); PG8_BAR; PG8_SCHED;
            PG8_LDA(At, 1, 1); PG8_STAGE(PG8_SB(1, 0), b3, offB); PG8_STAGE(PG8_SB(1, 1), b3 + hstepB, offB); PG8_STAGE(PG8_SA(1, 0), a3, offA);
            PG8_WAIT_V(8); PG8_WAIT_L(0); PG8_BAR; PG8_MMA(1, 0, At, B0); PG8_MMA(1, 1, At, B1); PG8_BAR; PG8_SCHED;
        }
        if (wr == 0) PG8_BAR;
        E(acc, cur, wr, wc, fr, fq, xlds, wid, lane);
        if (!has_next) break;
#pragma unroll
        for (int a = 0; a < 2; ++a)
#pragma unroll
            for (int b = 0; b < 2; ++b)
#pragma unroll
                for (int m = 0; m < 4; ++m)
#pragma unroll
                    for (int n = 0; n < 2; ++n) acc[a][b][m][n] = (f32x4){0.f, 0.f, 0.f, 0.f};
        cur = nxt; cA = nA; cB = nB; ++ui;
        if (wr == 1) PG8_BAR;
    }
    PG8_WAIT_V(0);
    PG8_BAR;
#undef PG8_SA
#undef PG8_SB
#undef PG8_STAGE
#undef PG8_STAGE_
#undef PG8_STAGE_offA
#undef PG8_STAGE_offB
#undef PG8_LDA
#undef PG8_LDB
#undef PG8_MMA
#undef PG8_UA
#undef PG8_UB
}
#define EPI_BAR() do { asm volatile("s_waitcnt lgkmcnt(0)" ::: "memory"); __builtin_amdgcn_s_barrier(); asm volatile("" ::: "memory"); } while (0)

struct EpiInProj {
    static constexpr bool PERM = true;
    unsigned char* wsb;
    __device__ __forceinline__ void operator()(f32x4 (&acc)[2][2][4][2], const Unit& u, int wr_, int wc_, int fr_, int fq_, LAS unsigned char* xlds, int wid, int lane) const {
        int wr = wr_, wc = wc_; asm volatile("" : "+s"(wr), "+s"(wc));
        int ln_; asm volatile("v_mbcnt_lo_u32_b32 %0, -1, 0\n\tv_mbcnt_hi_u32_b32 %0, -1, %0" : "=v"(ln_));
        const int fr = ln_ & 15, fq = ln_ >> 4; (void)fr_; (void)fq_;
        GAS unsigned char* ws = (GAS unsigned char*)wsb; asm volatile("" : "+s"(ws));
        const float* rstd0 = (const float*)(ws + WS_RSTD0); const float* bias = (const float*)(ws + WS_BIN); const float* gperm = (const float*)(ws + WS_GP); const f32x2* tab = (const f32x2*)(ws + WS_TAB);
        bf16_t* Q = (bf16_t*)(ws + WS_Q); bf16_t* KA = (bf16_t*)(ws + WS_KA); bf16_t* VA = (bf16_t*)(ws + WS_VA); bf16_t* BU = (bf16_t*)(ws + WS_BU);
        const int pm = u.pm, pn = u.pn;
        const int vec = pm < 32 ? 0 : (pm < 64 ? 1 : 2);
        const int c8 = wc * 32 + fq * 8;
        const float* bp = bias + vec * NIN + pn * 256 + c8;
        {
            f32x4 bv[2][2];
#pragma unroll
            for (int bj = 0; bj < 2; ++bj)
#pragma unroll
                for (int n = 0; n < 2; ++n) bv[bj][n] = *(const f32x4*)(bp + bj * 128 + 4 * n);
            float rs[2][4];
#pragma unroll
            for (int ai = 0; ai < 2; ++ai)
#pragma unroll
                for (int m = 0; m < 4; ++m) rs[ai][m] = rstd0[pm * 256 + ai * 128 + wr * 64 + m * 16 + fr];
#pragma unroll
            for (int ai = 0; ai < 2; ++ai) {
#pragma unroll
                for (int m = 0; m < 4; ++m)
#pragma unroll
                    for (int bj = 0; bj < 2; ++bj)
#pragma unroll
                        for (int n = 0; n < 2; ++n) acc[ai][bj][m][n] = acc[ai][bj][m][n] * rs[ai][m] + bv[bj][n];
            }
        }
        if (pn <= 2) {
            LAS float* X = (LAS float*)xlds;
#pragma unroll
            for (int ai = 0; ai < 2; ++ai)
#pragma unroll
                for (int m = 0; m < 4; ++m)
#pragma unroll
                    for (int bj = 0; bj < 2; ++bj) { const f32x4 a = acc[ai][bj][m][0], b = acc[ai][bj][m][1];
                        float s = (a[0] * a[0] + a[1] * a[1]) + (a[2] * a[2] + a[3] * a[3]) + (b[0] * b[0] + b[1] * b[1]) + (b[2] * b[2] + b[3] * b[3]);
                        s += __shfl_xor(s, 16); s += __shfl_xor(s, 32);
                        if (fq == 0) X[(ai * 128 + wr * 64 + m * 16 + fr) * 8 + bj * 4 + wc] = s; }
            EPI_BAR();
            const float* gp = gperm + (pn == 2 ? 128 : 0) + c8;
            const float qs = pn < 2 ? 0.088388347648318440f * 1.4426950408889634f : 1.0f;
            const f32x4 g0 = *(const f32x4*)(gp) * qs, g1 = *(const f32x4*)(gp + 4) * qs;
            f32x4 cr[2][2];
#define ROPE_LOAD(g_) do { const int rt_ = ((g_) >> 2) * 128 + wr * 64 + ((g_) & 3) * 16 + fr, t_ = (pm * 256 + rt_) & (SEQ - 1); const int base_ = (wc >= 2) ? (128 * 32 + (t_ & 63) * 32) : ((t_ >> 6) * 32); \
                const f32x2* tp_ = tab + base_ + (wc & 1) * 16 + fq * 4; cr[(g_) & 1][0] = *(const f32x4*)(tp_); cr[(g_) & 1][1] = *(const f32x4*)(tp_ + 2); } while (0)
            if (pm < 64) { ROPE_LOAD(0); }
#pragma unroll
            for (int ai = 0; ai < 2; ++ai)
#pragma unroll
                for (int m = 0; m < 4; ++m) {
                    const int rt = ai * 128 + wr * 64 + m * 16 + fr, row = pm * 256 + rt;
                    f32x4 c0 = {1.f, 0.f, 1.f, 0.f}, c1 = {1.f, 0.f, 1.f, 0.f};
                    if (pm < 64) { c0 = cr[(ai * 4 + m) & 1][0]; c1 = cr[(ai * 4 + m) & 1][1]; }
                    if (pm < 64 && ai * 4 + m + 1 < 8) ROPE_LOAD(ai * 4 + m + 1);
#pragma unroll
                    for (int bj = 0; bj < 2; ++bj) {
                        const f32x4 p4 = *(const LAS f32x4*)(X + rt * 8 + bj * 4);
                        const float rn = __builtin_amdgcn_rsqf(((p4[0] + p4[1]) + (p4[2] + p4[3])) * (1.0f / 128.0f) + EPS);
                        f32x4 a = acc[ai][bj][m][0] * rn * g0, b = acc[ai][bj][m][1] * rn * g1;
                        f32x4 ra = {a[0] * c0[0] - a[1] * c0[1], a[1] * c0[0] + a[0] * c0[1], a[2] * c0[2] - a[3] * c0[3], a[3] * c0[2] + a[2] * c0[3]};
                        f32x4 rb = {b[0] * c1[0] - b[1] * c1[1], b[1] * c1[0] + b[0] * c1[1], b[2] * c1[2] - b[3] * c1[3], b[3] * c1[2] + b[2] * c1[3]};
                        u32x4 w; w.x = cvtpk(ra[0], ra[1]); w.y = cvtpk(ra[2], ra[3]); w.z = cvtpk(rb[0], rb[1]); w.w = cvtpk(rb[2], rb[3]);
                        if (pn < 2) *(u32x4*)(Q + (size_t)row * 512 + pn * 256 + bj * 128 + c8) = w;
                        else { const size_t krow = pm < 64 ? (size_t)(pm >> 5) * SKV + CTXL + (row & (SEQ - 1)) : (size_t)(pm - 64) * SKV + rt;
                            *(u32x4*)(KA + krow * 256 + bj * 128 + c8) = w; }
                    }
                    asm volatile("" ::: "memory");
                }
#undef ROPE_LOAD
        } else if (pn == 3) {
#pragma unroll
            for (int ai = 0; ai < 2; ++ai)
#pragma unroll
                for (int m = 0; m < 4; ++m) { const int rt = ai * 128 + wr * 64 + m * 16 + fr, row = pm * 256 + rt;
                    const size_t krow = pm < 64 ? (size_t)(pm >> 5) * SKV + CTXL + (row & (SEQ - 1)) : (size_t)(pm - 64) * SKV + rt;
#pragma unroll
                    for (int bj = 0; bj < 2; ++bj) { const f32x4 a = acc[ai][bj][m][0], b = acc[ai][bj][m][1];
                        u32x4 w; w.x = cvtpk(a[0], a[1]); w.y = cvtpk(a[2], a[3]); w.z = cvtpk(b[0], b[1]); w.w = cvtpk(b[2], b[3]);
                        *(u32x4*)(VA + krow * 256 + bj * 128 + c8) = w; } }
        } else if (pn <= 5) {
#pragma unroll
            for (int ai = 0; ai < 2; ++ai)
#pragma unroll
                for (int m = 0; m < 4; ++m) { const size_t row = (size_t)pm * 256 + ai * 128 + wr * 64 + m * 16 + fr;
#pragma unroll
                    for (int bj = 0; bj < 2; ++bj) { const f32x4 a = acc[ai][bj][m][0], b = acc[ai][bj][m][1];
                        u32x4 w; w.x = cvtpk(a[0], a[1]); w.y = cvtpk(a[2], a[3]); w.z = cvtpk(b[0], b[1]); w.w = cvtpk(b[2], b[3]);
                        *(u32x4*)(BU + row * DM + (pn - 4) * 256 + bj * 128 + c8) = w; } }
        } else {
#pragma unroll
            for (int ai = 0; ai < 2; ++ai)
#pragma unroll
                for (int m = 0; m < 4; ++m) { const size_t row = (size_t)pm * 256 + ai * 128 + wr * 64 + m * 16 + fr;
                    const f32x4 a = acc[ai][0][m][0] * acc[ai][1][m][0], b = acc[ai][0][m][1] * acc[ai][1][m][1];
                    u32x4 w; w.x = cvtpk(a[0], a[1]); w.y = cvtpk(a[2], a[3]); w.z = cvtpk(b[0], b[1]); w.w = cvtpk(b[2], b[3]);
                    *(u32x4*)(BU + row * DM + 512 + (pn - 6) * 128 + c8) = w; }
        }
    }
};

struct EpiResid {
    static constexpr bool PERM = true;
    unsigned char* wsb; const KArgs* kpb; int k, probe;
    template <int RIN, int OUTF>
    __device__ __forceinline__ void body(f32x4 (&acc)[2][2][4][2], const Unit& u, int wr, int wc, int fr, int fq, GAS unsigned char* ws, const KArgs* kp) const {
        float* xout = kp->out;
        const float* resid32 = nullptr; (void)resid32;
        const bf16_t* xb = (const bf16_t*)(ws + WS_XB);
        bf16_t* outb = (bf16_t*)(ws + ((probe && k != 3) ? WS_TOP : WS_XB));
        const int gate_i = k == 0 ? 2 * DM : (k == 1 ? 5 * DM : (k == 2 ? 3 * NMOD + 2 * DM : 3 * NMOD + 5 * DM));
        const float* gate = (const float*)(ws + WS_MODF) + gate_i;
        const int gstride = NMOD;
        const int has_next = (OUTF || probe) ? 0 : 1;
        float* ssq = (float*)(ws + WS_SSQ + (size_t)(k == 3 ? 0 : k) * SSQ_BYTES);
        const int pm = u.pm, pn = u.pn, b = pm >> 5;
        const int c8 = wc * 32 + fq * 8, col0 = pn * 256 + c8;
        float ssum[8];
#pragma unroll
        for (int gi = 0; gi < 8; ++gi) ssum[gi] = 0.f;
        f32x4 gva[2][2], gsa[2][2];
        const float* gsp = kp->pool_scale;
#pragma unroll
        for (int bj = 0; bj < 2; ++bj)
#pragma unroll
            for (int n = 0; n < 2; ++n) { const int c = col0 + bj * 128 + n * 4; gva[bj][n] = *(const f32x4*)(gate + b * gstride + c); gsa[bj][n] = *(const f32x4*)(gsp + c); }
        asm volatile("" ::: "memory");
#pragma unroll
        for (int bj = 0; bj < 2; ++bj)
#pragma unroll
            for (int n = 0; n < 2; ++n) gva[bj][n] = k == 2 ? gva[bj][n] * gsa[bj][n] : gva[bj][n];
#pragma unroll
        for (int bj = 0; bj < 2; ++bj) {
            f32x4 gv[2]; gv[0] = gva[bj][0]; gv[1] = gva[bj][1];
            u32x4 rb[4];
#define RES_LOAD(g_) do { int fr_o = fr; asm volatile("" : "+v"(fr_o)); const size_t rw_ = (size_t)pm * 256 + ((g_) >> 2) * 128 + wr * 64 + ((g_) & 3) * 16 + fr_o;       \
            rb[(g_) & 3] = *(const u32x4*)(xb + rw_ * DM + col0 + bj * 128); } while (0)
            RES_LOAD(0); RES_LOAD(1); RES_LOAD(2);
#pragma unroll
            for (int gi = 0; gi < 8; ++gi) {
                const int ai = gi >> 2, m = gi & 3;
                int fr_s = fr; asm volatile("" : "+v"(fr_s));
                const size_t row = (size_t)pm * 256 + ai * 128 + wr * 64 + m * 16 + fr_s;
                if (gi + 3 < 8) RES_LOAD(gi + 3);
                const size_t off = row * DM + col0 + bj * 128;
                const u32x4 rw = rb[gi & 3];
                const f32x4 r0 = {bflo(rw.x), bfhi(rw.x), bflo(rw.y), bfhi(rw.y)}, r1 = {bflo(rw.z), bfhi(rw.z), bflo(rw.w), bfhi(rw.w)};
                const f32x4 o0 = r0 + gv[0] * acc[ai][bj][m][0], o1 = r1 + gv[1] * acc[ai][bj][m][1];
                if constexpr (OUTF) { __builtin_nontemporal_store(o0, (f32x4*)(xout + off)); __builtin_nontemporal_store(o1, (f32x4*)(xout + off + 4)); }
                else { u32x4 w_; w_.x = cvtpk(o0[0], o0[1]); w_.y = cvtpk(o0[2], o0[3]); w_.z = cvtpk(o1[0], o1[1]); w_.w = cvtpk(o1[2], o1[3]);
                    if (k == 1) *(u32x4*)(outb + off) = w_; else __builtin_nontemporal_store(w_, (u32x4*)(outb + off));
                    if (k == 1 && ((gi == 0 && wr == 0 && fr < 8) || (gi == 7 && wr == 1 && fr >= 8)))
                        *(u32x4*)((bf16_t*)(ws + WS_XE) + ((size_t)(pm * 4 + pn) * 16 + fr) * 256 + c8 + bj * 128) = w_; }
                if (has_next) { ssum[gi] += ((o0[0] * o0[0] + o0[1] * o0[1]) + (o0[2] * o0[2] + o0[3] * o0[3])) + ((o1[0] * o1[0] + o1[1] * o1[1]) + (o1[2] * o1[2] + o1[3] * o1[3])); asm volatile("" : "+v"(ssum[gi])); }
            }
#undef RES_LOAD
        }
        if (has_next) {
#pragma unroll
            for (int gi = 0; gi < 8; ++gi) { const size_t row = (size_t)pm * 256 + (gi >> 2) * 128 + wr * 64 + (gi & 3) * 16 + fr;
                float s = ssum[gi]; s += __shfl_xor(s, 16); s += __shfl_xor(s, 32); if (fq == 0) ssq[row * 16 + pn * 4 + wc] = s; }
        }
    }
    __device__ __forceinline__ void operator()(f32x4 (&acc)[2][2][4][2], const Unit& u, int wr_, int wc_, int fr_, int fq_, LAS unsigned char* xlds, int wid, int lane) const {
        int wr = wr_, wc = wc_; asm volatile("" : "+s"(wr), "+s"(wc));
        int ln_; asm volatile("v_mbcnt_lo_u32_b32 %0, -1, 0\n\tv_mbcnt_hi_u32_b32 %0, -1, %0" : "=v"(ln_));
        const int fr = ln_ & 15, fq = ln_ >> 4; (void)fr_; (void)fq_;
        GAS unsigned char* ws = (GAS unsigned char*)wsb; const KArgs* kp = kpb; asm volatile("" : "+s"(ws), "+s"(kp));
        if (k == 3) body<1, 1>(acc, u, wr, wc, fr, fq, ws, kp);
        else body<1, 0>(acc, u, wr, wc, fr, fq, ws, kp);
    }
};

__device__ __forceinline__ float dpp_f(float old, float src, int ctrl_sel) {
    const int o = __float_as_int(old), s = __float_as_int(src); int r;
    if (ctrl_sel == 0) r = __builtin_amdgcn_update_dpp(o, s, 0x111, 0xF, 0xF, false);
    else if (ctrl_sel == 1) r = __builtin_amdgcn_update_dpp(o, s, 0x101, 0xF, 0xF, false);
    else if (ctrl_sel == 2) r = __builtin_amdgcn_mov_dpp(s, 0x121, 0xF, 0xF, false);
    else r = __builtin_amdgcn_mov_dpp(s, 0x12F, 0xF, 0xF, false);
    return __int_as_float(r);
}
struct EpiFfnUp {
    static constexpr bool PERM = true;
    unsigned char* wsb; const KArgs* kpb; int l, cheap;
    __device__ __forceinline__ void operator()(f32x4 (&acc)[2][2][4][2], const Unit& u, int wr_, int wc_, int fr_, int fq_, LAS unsigned char* xlds, int wid, int lane) const {
        int wr = wr_, wc = wc_; asm volatile("" : "+s"(wr), "+s"(wc));
        int ln_; asm volatile("v_mbcnt_lo_u32_b32 %0, -1, 0\n\tv_mbcnt_hi_u32_b32 %0, -1, %0" : "=v"(ln_));
        const int fr = ln_ & 15, fq = ln_ >> 4; (void)fr_; (void)fq_;
        GAS unsigned char* ws = (GAS unsigned char*)wsb; const KArgs* kp = kpb; asm volatile("" : "+s"(ws), "+s"(kp));
        const float* ssq = (const float*)(ws + WS_SSQ + (size_t)(l ? 2 : 0) * SSQ_BYTES);
        const float* bias = (const float*)(ws + WS_BUP) + (size_t)l * 2 * NUP;
        const float* cw = kp->fconv_w + (size_t)l * 3 * DFF; const float* cb = kp->fconv_b + (size_t)l * DFF;
        bf16_t* H = (bf16_t*)(ws + WS_H); float* halo = (float*)(ws + WS_HALO);
        const int pm = u.pm, pn = u.pn, b = pm >> 5;
        const int c8 = wc * 32 + fq * 8, ch0 = pn * 128 + c8;
        if (cheap) {
#pragma unroll
            for (int ai = 0; ai < 2; ++ai)
#pragma unroll
                for (int m = 0; m < 4; ++m) { const size_t row = (size_t)pm * 256 + ai * 128 + wr * 64 + m * 16 + fr;
                    const f32x4 a = acc[ai][0][m][0] * acc[ai][1][m][0], c = acc[ai][0][m][1] * acc[ai][1][m][1];
                    u32x4 w; w.x = cvtpk(a[0], a[1]); w.y = cvtpk(a[2], a[3]); w.z = cvtpk(c[0], c[1]); w.w = cvtpk(c[2], c[3]);
                    *(u32x4*)(H + row * DFF + ch0) = w; }
            return;
        }
        const float* bp = bias + b * NUP + pn * 256 + c8;
        f32x4 bv[2][2], w0[2], w1[2], w2[2], cbv[2];
#pragma unroll
        for (int bj = 0; bj < 2; ++bj)
#pragma unroll
            for (int n = 0; n < 2; ++n) bv[bj][n] = *(const f32x4*)(bp + bj * 128 + 4 * n);
        LAS float* RS = (LAS float*)(xlds + 4096);
        volatile LAS int* RSPM = (volatile LAS int*)(xlds + 4096 + 1024);
        if (*RSPM != pm) {
            const int t = (wr * 4 + wc) * 64 + ln_, r = t >> 1, hf = t & 1; (void)wid; (void)lane;
            const f32x4* sp = (const f32x4*)(ssq + ((size_t)pm * 256 + r) * 16 + hf * 8); const f32x4 s0 = sp[0], s1 = sp[1];
            float tot = ((s0[0] + s0[1]) + (s0[2] + s0[3])) + ((s1[0] + s1[1]) + (s1[2] + s1[3]));
            tot += __shfl_xor(tot, 1);
            if (hf == 0) RS[r] = __builtin_amdgcn_rsqf(tot * (1.0f / DM) + EPS);
            EPI_BAR();
            if (t == 0) *RSPM = pm;
        }
#pragma unroll
        for (int ai = 0; ai < 2; ++ai)
#pragma unroll
            for (int m = 0; m < 4; ++m) { const float rs = RS[ai * 128 + wr * 64 + m * 16 + fr];
#pragma unroll
                for (int bj = 0; bj < 2; ++bj)
#pragma unroll
                    for (int n = 0; n < 2; ++n) acc[ai][bj][m][n] = acc[ai][bj][m][n] * rs + bv[bj][n]; }
        w0[0] = *(const f32x4*)(cw + ch0); w1[0] = *(const f32x4*)(cw + DFF + ch0); w2[0] = *(const f32x4*)(cw + 2 * DFF + ch0); cbv[0] = *(const f32x4*)(cb + ch0);
        LAS float* E = (LAS float*)xlds;
        if (fr == 0) {
#pragma unroll
            for (int ai = 0; ai < 2; ++ai)
#pragma unroll
                for (int n = 0; n < 2; ++n) *(LAS f32x4*)(E + ((ai * 2 + wr) * 2 + 0) * 128 + c8 + 4 * n) = acc[ai][0][0][n];
        }
        if (fr == 15) {
#pragma unroll
            for (int ai = 0; ai < 2; ++ai)
#pragma unroll
                for (int n = 0; n < 2; ++n) *(LAS f32x4*)(E + ((ai * 2 + wr) * 2 + 1) * 128 + c8 + 4 * n) = acc[ai][0][3][n];
        }
        EPI_BAR();
        w0[1] = *(const f32x4*)(cw + ch0 + 4); w1[1] = *(const f32x4*)(cw + DFF + ch0 + 4); w2[1] = *(const f32x4*)(cw + 2 * DFF + ch0 + 4); cbv[1] = *(const f32x4*)(cb + ch0 + 4);
        u32x2 hp0[4];
#pragma unroll
        for (int ai = 0; ai < 2; ++ai) {
#pragma unroll
            for (int n = 0; n < 2; ++n) {
                const int blk = ai * 2 + wr;
                const f32x4 eprev = blk > 0 ? *(const LAS f32x4*)(E + ((blk - 1) * 2 + 1) * 128 + c8 + 4 * n) : (f32x4){0.f, 0.f, 0.f, 0.f};
                const f32x4 enext = blk < 3 ? *(const LAS f32x4*)(E + ((blk + 1) * 2 + 0) * 128 + c8 + 4 * n) : (f32x4){0.f, 0.f, 0.f, 0.f};
#pragma unroll
                for (int m = 0; m < 4; ++m) {
                    const int rt = ai * 128 + wr * 64 + m * 16 + fr; const size_t row = (size_t)pm * 256 + rt;
                    f32x4 hv, pc;
#pragma unroll
                    for (int j = 0; j < 4; ++j) {
                        const float g = acc[ai][0][m][n][j];
                        float upe, dne;
                        if (m > 0) upe = dpp_f(0.f, acc[ai][0][m - 1][n][j], 2); else upe = eprev[j];
                        if (m < 3) dne = dpp_f(0.f, acc[ai][0][m + 1][n][j], 3); else dne = enext[j];
                        const float up = dpp_f(upe, g, 0), dn = dpp_f(dne, g, 1);
                        const float cv = w0[n][j] * up + w1[n][j] * g + w2[n][j] * dn + cbv[n][j];
                        pc[j] = cv; hv[j] = silu_f(cv) * acc[ai][1][m][n][j];
                    }
                    if (n == 0) { hp0[m].x = cvtpk(hv[0], hv[1]); hp0[m].y = cvtpk(hv[2], hv[3]); }
                    else { u32x4 w; w.x = hp0[m].x; w.y = hp0[m].y; w.z = cvtpk(hv[0], hv[1]); w.w = cvtpk(hv[2], hv[3]);
                        st16_wt(H + row * DFF + ch0, w); }
                    if ((m == 0 && blk == 0 && fr == 0) || (m == 3 && blk == 3 && fr == 15)) {
                        float* hp = halo + ((size_t)(pm * 22 + pn) * 6 + (m == 0 ? 0 : 3)) * 128 + c8 + 4 * n;
                        *(f32x4*)(hp) = pc; *(f32x4*)(hp + 128) = acc[ai][1][m][n]; *(f32x4*)(hp + 256) = acc[ai][0][m][n];
                    }
                }
                asm volatile("" ::: "memory");
            }
        }
    }
};
}

namespace attn {
using bf16 = __hip_bfloat16;
using s16x4 = __attribute__((ext_vector_type(4))) short;
using f32x16 = __attribute__((ext_vector_type(16))) float;
constexpr int D = 128, NW = 8, QBLK = 32, KVBLK = 64;
constexpr float SCALE = 0.088388347648318440f;
constexpr float THR = 8.f;
constexpr int LDQ = 512, LDK = 256, LDO = 1024;
constexpr size_t SHM_V = KVBLK * D * 2, SHM_K = KVBLK * D * 2, SHM_ATTN = 2 * SHM_V + 2 * SHM_K + NW * 64 * 4;
#define KSWZ(row, colB) ((row) * 256 + ((colB) ^ (((row) & 7) << 4)))
#define SBAR() __builtin_amdgcn_sched_barrier(0)
__device__ __forceinline__ int crow(int r, int hi) { return (r & 3) + 8 * (r >> 2) + 4 * hi; }
__device__ __forceinline__ unsigned cvtpk_a(float lo, float hi) { unsigned r; asm volatile("v_cvt_pk_bf16_f32 %0, %1, %2" : "=v"(r) : "v"(lo), "v"(hi)); return r; }
__device__ __forceinline__ bf16x8 ld8(const bf16* p) { return *reinterpret_cast<const bf16x8*>(p); }

template <bool FIRST>
__device__ __forceinline__ void partialSM(f32x16& p0, f32x16& p1, float& m_reg, f32x16& negm, float& alpha) {
  constexpr float THRL = THR * 1.4426950408889634f;
  float pmax = p0[0]; for (int r = 1; r < 16; ++r) pmax = fmaxf(pmax, p0[r]); for (int r = 0; r < 16; ++r) pmax = fmaxf(pmax, p1[r]);
  { auto rr = __builtin_amdgcn_permlane32_swap(__float_as_uint(pmax), __float_as_uint(pmax), false, false);
    pmax = fmaxf(__uint_as_float(rr[0]), __uint_as_float(rr[1])); }
  if (!FIRST && __builtin_expect(__all(pmax <= THRL), 1)) { alpha = 1.f; }
  else { const float d = FIRST ? pmax : fmaxf(pmax, 0.f); alpha = FIRST ? 1.f : __builtin_amdgcn_exp2f(-d); m_reg += d;
    for (int r = 0; r < 16; ++r) p0[r] -= d; for (int r = 0; r < 16; ++r) p1[r] -= d;
    for (int r = 0; r < 16; ++r) negm[r] = -m_reg; }
  for (int r = 0; r < 16; ++r) p0[r] = __builtin_amdgcn_exp2f(p0[r]);
}
__device__ __forceinline__ void finishSM(f32x16& p0, f32x16& p1, float alpha, float& l_reg, bf16x8& pa0, bf16x8& pa1, bf16x8& pa2, bf16x8& pa3) {
  for (int r = 0; r < 16; ++r) p1[r] = __builtin_amdgcn_exp2f(p1[r]);
  float ps = 0; for (int r = 0; r < 16; ++r) ps += p0[r]; for (int r = 0; r < 16; ++r) ps += p1[r];
  { auto rr = __builtin_amdgcn_permlane32_swap(__float_as_uint(ps), __float_as_uint(ps), false, false);
    ps = __uint_as_float(rr[0]) + __uint_as_float(rr[1]); }
  l_reg = l_reg * alpha + ps;
#define PK4(P, BASE, OUT) do { unsigned a0 = cvtpk_a(P[BASE + 0], P[BASE + 1]), a1 = cvtpk_a(P[BASE + 2], P[BASE + 3]);   \
    unsigned b0 = cvtpk_a(P[BASE + 4], P[BASE + 5]), b1 = cvtpk_a(P[BASE + 6], P[BASE + 7]);                              \
    auto r0 = __builtin_amdgcn_permlane32_swap(a0, b0, false, false); auto r1 = __builtin_amdgcn_permlane32_swap(a1, b1, false, false); \
    u32x4 w = {r0[0], r1[0], r0[1], r1[1]}; OUT = *reinterpret_cast<bf16x8*>(&w); } while (0)
  PK4(p0, 0, pa0); PK4(p0, 8, pa1); PK4(p1, 0, pa2); PK4(p1, 8, pa3);
#undef PK4
}
__device__ __forceinline__ void qkt(f32x16& p0, f32x16& p1, const bf16* Ks, const bf16x8* qr, int r32, int hi, const f32x16& negm) {
  for (int d0 = 0; d0 < 8; ++d0) { int cb = (d0 * 16 + hi * 8) * 2;
    bf16x8 b0 = *reinterpret_cast<const bf16x8*>((const char*)Ks + KSWZ(r32, cb));
    bf16x8 b1 = *reinterpret_cast<const bf16x8*>((const char*)Ks + KSWZ(32 + r32, cb));
    p0 = __builtin_amdgcn_mfma_f32_32x32x16_bf16(b0, qr[d0], d0 == 0 ? negm : p0, 0, 0, 0);
    p1 = __builtin_amdgcn_mfma_f32_32x32x16_bf16(b1, qr[d0], d0 == 0 ? negm : p1, 0, 0, 0); }
}
__device__ __forceinline__ int v_st(int k, int c) { const int kk = (k & ~0xC) | ((k & 4) << 1) | ((k & 8) >> 1); return ((kk >> 3) * 4 + (c >> 5)) * 512 + ((kk & 7) * 32 + (c & 31)) * 2; }
__device__ __forceinline__ int v_rd_base(int lane) { return ((lane & 3) << 3) | (((lane >> 2) & 3) << 6) | (((lane >> 4) & 1) << 5) | (((lane >> 5) & 1) << 8); }
constexpr int v_rd_off(int d0, int ks, int half) { return d0 * 512 + ks * 4096 + half * 2048; }
template <int OFF> __device__ __forceinline__ s16x4 tr_read(int vb) {
  s16x4 r; asm volatile("ds_read_b64_tr_b16 %0, %1 offset:%2" : "=&v"(r) : "v"(vb), "i"(OFF) : "memory"); return r;
}
template <int D0> __device__ __forceinline__ void pv_one(f32x16& od, int vb, bf16x8 pa0, bf16x8 pa1, bf16x8 pa2, bf16x8 pa3) {
  const s16x4 l0 = tr_read<v_rd_off(D0, 0, 0)>(vb), h0 = tr_read<v_rd_off(D0, 0, 1)>(vb), l1 = tr_read<v_rd_off(D0, 1, 0)>(vb), h1 = tr_read<v_rd_off(D0, 1, 1)>(vb);
  const s16x4 l2 = tr_read<v_rd_off(D0, 2, 0)>(vb), h2 = tr_read<v_rd_off(D0, 2, 1)>(vb), l3 = tr_read<v_rd_off(D0, 3, 0)>(vb), h3 = tr_read<v_rd_off(D0, 3, 1)>(vb);
  asm volatile("s_waitcnt lgkmcnt(0)" ::: "memory"); SBAR();
#define PK(L, H) (bf16x8){L[0], L[1], L[2], L[3], H[0], H[1], H[2], H[3]}
  od = __builtin_amdgcn_mfma_f32_32x32x16_bf16(pa0, PK(l0, h0), od, 0, 0, 0);
  od = __builtin_amdgcn_mfma_f32_32x32x16_bf16(pa1, PK(l1, h1), od, 0, 0, 0);
  od = __builtin_amdgcn_mfma_f32_32x32x16_bf16(pa2, PK(l2, h2), od, 0, 0, 0);
  od = __builtin_amdgcn_mfma_f32_32x32x16_bf16(pa3, PK(l3, h3), od, 0, 0, 0);
#undef PK
}
__device__ __forceinline__ void pv_d0(f32x16* o, int vb, bf16x8 pa0, bf16x8 pa1, bf16x8 pa2, bf16x8 pa3) {
  pv_one<0>(o[0], vb, pa0, pa1, pa2, pa3); pv_one<1>(o[1], vb, pa0, pa1, pa2, pa3); pv_one<2>(o[2], vb, pa0, pa1, pa2, pa3); pv_one<3>(o[3], vb, pa0, pa1, pa2, pa3);
}

__device__ __forceinline__ void attn_dense_body(const bf16* Qb, const bf16* Kh, const bf16* Vh, bf16* Ob, int seq, char* lds, LAS unsigned char* ldsl, const int tid) {
  const int lane = tid & 63, r32 = lane & 31, hi = lane >> 5;
  const int widu = __builtin_amdgcn_readfirstlane(tid >> 6), wid = widu;
  constexpr int NBUF = 4;
  bf16* V_lds = (bf16*)lds; bf16* K_lds = (bf16*)(lds + NBUF * SHM_V);
  float* ws = (float*)(lds + NBUF * SHM_V + NBUF * SHM_K) + widu * 64; float* li_l = ws; float* al_l = ws + 32;
  float m_reg = 0.f, l_reg = 0; f32x16 o[4] = {}; bf16x8 qr[8]; f32x16 negm = {};
  const bf16* Qw = Qb + (long)(wid * QBLK + r32) * LDQ + hi * 8;
#pragma unroll
  for (int d0 = 0; d0 < 8; ++d0) qr[d0] = ld8(Qw + d0 * 16);
  const int vb0 = (int)(uintptr_t)V_lds + v_rd_base(lane);
  unsigned kso0, vso0;
  { const int P = (2 * widu) * 1024 + 16 * lane;
    { const int row = P >> 8, cbs = P & 255, cb = cbs ^ ((row & 7) << 4); kso0 = (unsigned)(row * (LDK * 2) + cb); }
    { const int blk = P >> 9, wb = P & 511, kk = (blk >> 2) * 8 + (wb >> 6), c = (blk & 3) * 32 + ((wb & 63) >> 1);
      const int k = (kk & ~0xC) | ((kk & 4) << 1) | ((kk & 8) >> 1); vso0 = (unsigned)(k * (LDK * 2) + c * 2); } }
  asm volatile("" : "+v"(kso0), "+v"(vso0));
#define TDMA_(t_, isk_) do { const int b_ = (t_) & (NBUF - 1); const char* st_ = (const char*)((isk_) ? Kh : Vh) + (size_t)(t_) * (KVBLK * LDK * 2); \
    _Pragma("unroll") for (int i_ = 0; i_ < 2; ++i_) { const unsigned so_ = (isk_) ? (i_ ? (kso0 ^ 64u) + 4u * (LDK * 2) : kso0) : (i_ ? vso0 + 128u : vso0); \
      __builtin_amdgcn_global_load_lds((const unsigned*)(st_ + so_), (LAS unsigned*)(ldsl + ((isk_) ? NBUF * SHM_V + b_ * SHM_K : b_ * SHM_V) + (2 * widu + i_) * 1024), 16, 0, 0); } } while (0)
#define TDMAK(t_) TDMA_(t_, 1)
#define TDMAV(t_) TDMA_(t_, 0)
#define TWAIT0() asm volatile("s_waitcnt vmcnt(0)" ::: "memory")
#define TBAR() do { asm volatile("s_waitcnt lgkmcnt(0)" ::: "memory"); __builtin_amdgcn_s_barrier(); asm volatile("" ::: "memory"); } while (0)
#define KBUF(t_) ((bf16*)((char*)K_lds + ((t_) & (NBUF - 1)) * SHM_K))
#define VBUF(t_) (vb0 + ((t_) & (NBUF - 1)) * (int)SHM_V)
#define RESC(a) do { if (__any((a) < 1.f)) { if (hi == 0) al_l[r32] = (a); asm volatile("s_waitcnt lgkmcnt(0)" ::: "memory"); \
    for (int d = 0; d < 4; ++d) for (int r = 0; r < 16; ++r) o[d][r] *= al_l[crow(r, hi)]; } } while (0)
#define TSYNC(b_) do { TWAIT0(); TBAR(); if ((b_) + 3 < NT) TDMAK((b_) + 3); if ((b_) + 2 < NT) TDMAV((b_) + 2); } while (0)
#define TITER(t_, c0, c1, alc, p0, p1, alp, FIRST_) do { \
    SBAR(); qkt(c0, c1, KBUF(t_), qr, r32, hi, negm); \
    if (hB) TSYNC(t_); \
    if (!(FIRST_)) { finishSM(p0, p1, alp, l_reg, pa0, pa1, pa2, pa3); SBAR(); pv_d0(o, VBUF((t_) - 1), pa0, pa1, pa2, pa3); } \
    partialSM<FIRST_>(c0, c1, m_reg, negm, alc); RESC(alc); \
    if (!hB) TSYNC(t_); } while (0)
  f32x16 pA0, pA1, pB0, pB1; float alA = 1.f, alB = 1.f; bf16x8 pa0, pa1, pa2, pa3; const int NT = seq / KVBLK;
  const bool hB = widu >= 4;
  TDMAK(0); TDMAK(1); TDMAV(0);
  TWAIT0(); TBAR();
  TDMAK(2); TDMAV(1);
  TITER(0, pA0, pA1, alA, pB0, pB1, alB, true);
  TITER(1, pB0, pB1, alB, pA0, pA1, alA, false);
  for (int t = 2; t < NT; t += 2) {
    TITER(t, pA0, pA1, alA, pB0, pB1, alB, false);
    TITER(t + 1, pB0, pB1, alB, pA0, pA1, alA, false);
  }
  finishSM(pB0, pB1, alB, l_reg, pa0, pa1, pa2, pa3); SBAR();
  pv_d0(o, VBUF(NT - 1), pa0, pa1, pa2, pa3);
  if (hi == 0) li_l[r32] = l_reg; asm volatile("s_waitcnt lgkmcnt(0)" ::: "memory");
  float rli[16];
#pragma unroll
  for (int r = 0; r < 16; ++r) rli[r] = __builtin_amdgcn_rcpf(li_l[crow(r, hi)]);
  { int r32e = r32, hie = hi; asm volatile("" : "+v"(r32e), "+v"(hie));
    bf16* Ow = Ob + (wid * QBLK + 4 * hie) * LDO + r32e;
#pragma unroll
    for (int r = 0; r < 16; ++r) { const int orow = (r & 3) + 8 * (r >> 2);
#pragma unroll
      for (int d0 = 0; d0 < 4; ++d0) Ow[orow * LDO + d0 * 32] = __float2bfloat16(o[d0][r] * rli[r]); } }
#undef TDMA_
#undef TDMAK
#undef TDMAV
#undef TSYNC
#undef TITER
#undef TWAIT0
#undef TBAR
#undef KBUF
#undef VBUF
#undef RESC
}
#undef KSWZ
#undef SBAR
}

#define XB_TMO      128
#define XB_XCNT(j)  (256  + 64 * (j))
#define XB_XSUB(j)  (1280 + 64 * (j))
#define XB_XGEN(j)  (2304 + 64 * (j))
#define XB_TOP      3328
#define XB_TOPGEN   3392
#define XCD_BAR_WORDS 3456
#define XB_SPIN_CAP (1u << 18)
__device__ __forceinline__ unsigned xb_ld(unsigned* p)              { return __hip_atomic_load(p, __ATOMIC_RELAXED, __HIP_MEMORY_SCOPE_AGENT); }
__device__ __forceinline__ unsigned xb_add(unsigned* p, unsigned v) { return __hip_atomic_fetch_add(p, v, __ATOMIC_RELAXED, __HIP_MEMORY_SCOPE_AGENT); }
__device__ __forceinline__ unsigned xb_xcc_id() { return (unsigned)__builtin_amdgcn_s_getreg((3 << 11) | 20) & 0xFu; }
#define XB_SPIN(cond, bar) do { unsigned _sp = 0; while (cond) { __builtin_amdgcn_s_sleep(1); \
    if ((++_sp & 255u) == 0u) { if (xb_ld(&(bar)[XB_TMO])) break; if (_sp > XB_SPIN_CAP) { atomicAdd(&(bar)[XB_TMO], 1u); break; } } } } while (0)
struct XcdBarrier { unsigned* bar; unsigned x; unsigned G; volatile LAS unsigned* st; };
__device__ __forceinline__ XcdBarrier xcd_barrier_post(unsigned* bar, volatile LAS unsigned* st, unsigned G, bool t0) {
    XcdBarrier b; b.bar = bar; b.x = xb_xcc_id(); b.st = st; b.G = G;
    if (t0) (void)xb_add(&bar[XB_XCNT(b.x)], 1u);
    return b;
}
__device__ __forceinline__ void xcd_barrier_complete(unsigned* bar, unsigned x, unsigned G, unsigned& nloc, unsigned& nx) {
    unsigned sum, cnt, mine, sp = 0u;
    for (;;) {
        sum = 0u; cnt = 0u; mine = 0u;
#pragma unroll
        for (unsigned j = 0; j < 16; ++j) { const unsigned c = xb_ld(&bar[XB_XCNT(j)]); sum += c; cnt += (c > 0u) ? 1u : 0u; mine = (j == x) ? c : mine; }
        if (sum == G) break;
        __builtin_amdgcn_s_sleep(1);
        if ((++sp & 255u) == 0u) { if (xb_ld(&bar[XB_TMO])) break; if (sp > XB_SPIN_CAP) { atomicAdd(&bar[XB_TMO], 1u); break; } }
    }
    nloc = mine > 0u ? mine : 1u; nx = cnt > 0u ? cnt : 1u;
}
__device__ __forceinline__ void xcd_barrier(const XcdBarrier& b, bool t0) {
    asm volatile("s_waitcnt vmcnt(0)" ::: "memory");
    __syncthreads();
    if (t0) {
        unsigned* bar = b.bar;
        __builtin_amdgcn_s_waitcnt(0);
        unsigned nloc = b.st[0], nx = b.st[1];
        if (nloc == 0u) { xcd_barrier_complete(bar, b.x, b.G, nloc, nx); b.st[0] = nloc; b.st[1] = nx; }
        const unsigned old = xb_add(&bar[XB_XSUB(b.x)], 1u);
        const unsigned gen = old / nloc;
        if (old + 1u == (gen + 1u) * nloc) {
            __builtin_amdgcn_fence(__ATOMIC_RELEASE, "agent");
            asm volatile("s_waitcnt vmcnt(0)" ::: "memory");
            const unsigned og = xb_add(&bar[XB_TOP], 1u);
            const unsigned tg = og / nx;
            if (og + 1u == (tg + 1u) * nx) xb_add(&bar[XB_TOPGEN], 1u);
            else XB_SPIN(xb_ld(&bar[XB_TOPGEN]) == tg, bar);
            __builtin_amdgcn_fence(__ATOMIC_ACQUIRE, "agent");
            xb_add(&bar[XB_XGEN(b.x)], 1u);
            asm volatile("s_waitcnt vmcnt(0)" ::: "memory");
        } else {
            XB_SPIN(xb_ld(&bar[XB_XGEN(b.x)]) == gen, bar);
            asm volatile("buffer_inv sc0" ::: "memory");
            asm volatile("s_waitcnt vmcnt(0)" ::: "memory");
        }
    }
    __syncthreads();
}


template <int NV>
__device__ __forceinline__ float gemv64(const float* W, int ldw, int col0, const LAS float* vecs, LAS float* red, int tid) {
    const int cg = tid & 15, kg = tid >> 4;
    f32x4 a[NV];
#pragma unroll
    for (int v = 0; v < NV; ++v) a[v] = (f32x4){0.f, 0.f, 0.f, 0.f};
    const float* wp = W + (size_t)kg * ldw + col0 + cg * 4;
    f32x4 w[32];
#pragma unroll
    for (int i = 0; i < 32; ++i) w[i] = __builtin_nontemporal_load((const f32x4*)(wp + (size_t)i * 32 * ldw));
    asm volatile("" ::: "memory");
#pragma unroll
    for (int i = 0; i < 32; ++i) { const int k = kg + 32 * i;
#pragma unroll
        for (int v = 0; v < NV; ++v) a[v] += w[i] * vecs[v * 1024 + k]; }
#pragma unroll
    for (int v = 0; v < NV; ++v) *(LAS f32x4*)(red + (kg * 16 + cg) * (4 * NV) + v * 4) = a[v];
    LDS_WAIT(); __syncthreads();
    float s = 0.f;
    if (tid < 64 * NV) { const int v = tid >> 6, c = tid & 63;
#pragma unroll 8
        for (int g = 0; g < 32; ++g) s += red[(g * 16 + (c >> 2)) * (4 * NV) + v * 4 + (c & 3)]; }
    __syncthreads();
    return s;
}

template <int MAP>
__device__ __forceinline__ void transpose_item(const float* W, int K, int N, bf16_t* WT, LAS float* scr, int item, int lane) {
    const int nblk = N / 32, kb = item / nblk, nb = item % nblk, k0 = 64 * kb, n0 = 32 * nb;
    f32x4 v[8];
#pragma unroll
    for (int i = 0; i < 8; ++i) v[i] = __builtin_nontemporal_load((const f32x4*)(W + (size_t)(k0 + 8 * i + (lane >> 3)) * N + n0 + 4 * (lane & 7)));
#pragma unroll
    for (int i = 0; i < 8; ++i) { LAS float* d = scr + (8 * i + (lane >> 3)) * 33 + 4 * (lane & 7); d[0] = v[i][0]; d[1] = v[i][1]; d[2] = v[i][2]; d[3] = v[i][3]; }
    LDS_WAIT(); asm volatile("" ::: "memory");
    const int c = lane & 7;
#pragma unroll
    for (int j = 0; j < 4; ++j) { const int n = (lane >> 3) + 8 * j; const LAS float* sp = scr + (8 * c) * 33 + n;
        u32x4 o; o.x = cvtpk(sp[0 * 33], sp[1 * 33]); o.y = cvtpk(sp[2 * 33], sp[3 * 33]); o.z = cvtpk(sp[4 * 33], sp[5 * 33]); o.w = cvtpk(sp[6 * 33], sp[7 * 33]);
        const int src = n0 + n; const int dst = MAP == 1 ? map_in(src) : (MAP == 2 ? map_up(src) : src);
        *(u32x4*)(WT + (size_t)dst * K + k0 + 8 * c) = o; }
    LDS_WAIT(); asm volatile("" ::: "memory");
}


template <int HW>
__device__ __forceinline__ void pool_rows32(const bf16_t* xb, const bf16_t* xe_prev, const bf16_t* xe_next, int tile0, int t0, float rs_l, f32x4 nv, bf16_t* dst) {
    constexpr int NW = 8 + 2 * HW;
#define PR_PTR(t) ({ const int tc_ = (t) < 0 ? 0 : ((t) >= SEQ ? SEQ - 1 : (t)); const int tl_ = tc_ - tile0; \
        (tl_ < 0) ? xe_prev + (size_t)(16 + tl_) * 256 : ((tl_ >= 256) ? xe_next + (size_t)(tl_ - 256) * 256 : xb + (size_t)tc_ * DM); })
#define PR_RS(t) __int_as_float(__builtin_amdgcn_readlane(__float_as_int(rs_l), (t) - t0 + 8))
#define PR_CVT(w_) ((f32x4){bflo((w_).x), bfhi((w_).x), bflo((w_).y), bfhi((w_).y)})
    f32x4 win[NW]; u32x2 raw[NW + 24];
#pragma unroll
    for (int j = 0; j < NW + 24; ++j) raw[j] = *(const u32x2*)PR_PTR(t0 - HW + j);
#pragma unroll
    for (int j = 0; j < NW; ++j) win[j] = PR_CVT(raw[j]) * PR_RS(t0 - HW + j);
#pragma unroll
    for (int blk = 0; blk < 4; ++blk) {
        f32x4 S = win[0];
#pragma unroll
        for (int j = 1; j < 2 * HW; ++j) S += win[j];
#pragma unroll
        for (int o = 0; o < 8; ++o) { const int t = t0 + 8 * blk + o;
            const int a0 = t - HW < 0 ? 0 : t - HW, e0 = t + HW > SEQ ? SEQ : t + HW;
            const f32x4 pv = (S * (1.0f / (float)(e0 - a0)) - win[o + HW]) * nv;
            u32x2 w; w.x = cvtpk(pv[0], pv[1]); w.y = cvtpk(pv[2], pv[3]);
            *(u32x2*)(dst + (size_t)t * DM) = w;
            S += win[o + 2 * HW]; S -= win[o]; }
        if (blk < 3) {
#pragma unroll
            for (int j = 0; j < 2 * HW; ++j) win[j] = win[j + 8];
#pragma unroll
            for (int j = 0; j < 8; ++j) win[2 * HW + j] = PR_CVT(raw[NW + 8 * blk + j]) * PR_RS(t0 - HW + 8 * (blk + 1) + 2 * HW + j);
        }
    }
#undef PR_PTR
#undef PR_RS
#undef PR_CVT
}

__device__ __forceinline__ void transpose_item_in(const float* W, bf16_t* WT, const float* nrm, const float* sc0, LAS float* scr, int item, int lane) {
    constexpr int K = DM, N = NIN;
    const int nblk = N / 32, kb = item / nblk, nb = item % nblk, k0 = 64 * kb, n0 = 32 * nb;
    f32x4 v[8];
#pragma unroll
    for (int i = 0; i < 8; ++i) v[i] = __builtin_nontemporal_load((const f32x4*)(W + (size_t)(k0 + 8 * i + (lane >> 3)) * N + n0 + 4 * (lane & 7)));
    const int c = lane & 7;
    const f32x4 na = *(const f32x4*)(nrm + k0 + 8 * c), nb4 = *(const f32x4*)(nrm + k0 + 8 * c + 4);
#pragma unroll
    for (int i = 0; i < 8; ++i) { LAS float* d = scr + (8 * i + (lane >> 3)) * 33 + 4 * (lane & 7); d[0] = v[i][0]; d[1] = v[i][1]; d[2] = v[i][2]; d[3] = v[i][3]; }
    LDS_WAIT(); asm volatile("" ::: "memory");
#pragma unroll
    for (int vv = 0; vv < 3; ++vv) {
        const float* sc = sc0 + (size_t)vv * NMOD;
        const f32x4 sa = na * (1.0f + *(const f32x4*)(sc + k0 + 8 * c)), sb = nb4 * (1.0f + *(const f32x4*)(sc + k0 + 8 * c + 4));
#pragma unroll
        for (int j = 0; j < 4; ++j) { const int n = (lane >> 3) + 8 * j; const LAS float* sp = scr + (8 * c) * 33 + n;
            u32x4 o; o.x = cvtpk(sp[0 * 33] * sa[0], sp[1 * 33] * sa[1]); o.y = cvtpk(sp[2 * 33] * sa[2], sp[3 * 33] * sa[3]); o.z = cvtpk(sp[4 * 33] * sb[0], sp[5 * 33] * sb[1]); o.w = cvtpk(sp[6 * 33] * sb[2], sp[7 * 33] * sb[3]);
            *(u32x4*)(WT + (size_t)vv * N * K + (size_t)map_in(n0 + n) * K + k0 + 8 * c) = o; }
    }
    LDS_WAIT(); asm volatile("" ::: "memory");
}
__device__ __forceinline__ void transpose_item_up(const float* W, bf16_t* WT, const float* nrm, const float* sc0, const float* sc1, LAS float* scr, int item, int lane) {
    constexpr int K = DM, N = NUP;
    const int nblk = N / 32, kb = item / nblk, nb = item % nblk, k0 = 64 * kb, n0 = 32 * nb;
    f32x4 v[8];
#pragma unroll
    for (int i = 0; i < 8; ++i) v[i] = __builtin_nontemporal_load((const f32x4*)(W + (size_t)(k0 + 8 * i + (lane >> 3)) * N + n0 + 4 * (lane & 7)));
    const int c = lane & 7;
    const f32x4 na = *(const f32x4*)(nrm + k0 + 8 * c), nb4 = *(const f32x4*)(nrm + k0 + 8 * c + 4);
    const f32x4 s0a = na * (1.0f + *(const f32x4*)(sc0 + k0 + 8 * c)), s0b = nb4 * (1.0f + *(const f32x4*)(sc0 + k0 + 8 * c + 4));
    const f32x4 s1a = na * (1.0f + *(const f32x4*)(sc1 + k0 + 8 * c)), s1b = nb4 * (1.0f + *(const f32x4*)(sc1 + k0 + 8 * c + 4));
#pragma unroll
    for (int i = 0; i < 8; ++i) { LAS float* d = scr + (8 * i + (lane >> 3)) * 33 + 4 * (lane & 7); d[0] = v[i][0]; d[1] = v[i][1]; d[2] = v[i][2]; d[3] = v[i][3]; }
    LDS_WAIT(); asm volatile("" ::: "memory");
#pragma unroll
    for (int j = 0; j < 4; ++j) { const int n = (lane >> 3) + 8 * j; const LAS float* sp = scr + (8 * c) * 33 + n;
        const float w0 = sp[0 * 33], w1 = sp[1 * 33], w2 = sp[2 * 33], w3 = sp[3 * 33], w4 = sp[4 * 33], w5 = sp[5 * 33], w6 = sp[6 * 33], w7 = sp[7 * 33];
        u32x4 o0, o1;
        o0.x = cvtpk(w0 * s0a[0], w1 * s0a[1]); o0.y = cvtpk(w2 * s0a[2], w3 * s0a[3]); o0.z = cvtpk(w4 * s0b[0], w5 * s0b[1]); o0.w = cvtpk(w6 * s0b[2], w7 * s0b[3]);
        o1.x = cvtpk(w0 * s1a[0], w1 * s1a[1]); o1.y = cvtpk(w2 * s1a[2], w3 * s1a[3]); o1.z = cvtpk(w4 * s1b[0], w5 * s1b[1]); o1.w = cvtpk(w6 * s1b[2], w7 * s1b[3]);
        const int dst = map_up(n0 + n);
        *(u32x4*)(WT + (size_t)dst * K + k0 + 8 * c) = o0;
        *(u32x4*)(WT + (size_t)N * K + (size_t)dst * K + k0 + 8 * c) = o1; }
    LDS_WAIT(); asm volatile("" ::: "memory");
}

constexpr int I_IN = (DM / 64) * (NIN / 32), I_OUT = (DM / 64) * (DM / 32), I_POOL = (256 / 64) * (256 / 32), I_UP = (DM / 64) * (NUP / 32), I_DN = (DFF / 64) * (DM / 32);
constexpr int IT_OUT = I_IN, IT_POOL = IT_OUT + I_OUT, IT_UP = IT_POOL + 4 * I_POOL, IT_DN = IT_UP + 2 * I_UP, IT_END = IT_DN + 2 * I_DN;
#ifndef PH_MASK
#define PH_MASK 0xFFFF
#endif
#define PHM(x) (((PH_MASK) >> (x)) & 1)
enum Phase { PH_MOD = 0, PH_PREP, PH_INPROJ, PH_ATTN, PH_OUTPROJ, PH_UP0, PH_DOWN0, PH_POOLG, PH_UP1, PH_DOWN1, PH_COUNT };

__global__ void __launch_bounds__(NTHREADS, 2) fwd_kernel(Args args) {
    __shared__ __attribute__((aligned(16))) unsigned char lds_raw[LDS_BYTES];
    LAS unsigned char* lds = (LAS unsigned char*)lds_raw;
    LAS unsigned char* xlds = lds + XCH_OFF;
    volatile LAS unsigned* MISC = (volatile LAS unsigned*)(lds + MISC_OFF);
    const int G = args.grid, bid = blockIdx.x;
    const int vcu = (G % 8 == 0) ? (bid % 8) * (G / 8) + bid / 8 : bid;
    const int wave_s = __builtin_amdgcn_readfirstlane((int)threadIdx.x >> 6);
#define TID_NOW() ({ int l_; asm volatile("v_mbcnt_lo_u32_b32 %0, -1, 0\n\tv_mbcnt_hi_u32_b32 %0, -1, %0" : "=v"(l_)); wave_s * 64 + l_; })
    for (int u = TID_NOW(); u < 64; u += NTHREADS) MISC[u] = 0u;
    __syncthreads();
    const int lo = args.ph_lo, hi = args.ph_hi;
    const bool use_bar = (hi - lo) > 1;
    XcdBarrier bar; bar.bar = (unsigned*)(args.ws + WS_CTL) + 4096; bar.x = 0; bar.G = (unsigned)G; bar.st = MISC + 8;
    if (use_bar) bar = xcd_barrier_post((unsigned*)(args.ws + WS_CTL) + 4096, MISC + 8, (unsigned)G, TID_NOW() == 0);

#define TRANSPOSE_IT(it_) do { int r_ = (it_); \
        if (r_ < IT_OUT) { transpose_item_in(kp->w_in, Win_t, kp->mix_norm, modf + DM, scr, r_, lane); } \
        else if (r_ < IT_POOL) { transpose_item<0>(kp->w_out, DM, DM, Wout_t, scr, r_ - IT_OUT, lane); } \
        else if (r_ < IT_UP) { r_ -= IT_POOL; const int gi_ = r_ / I_POOL; transpose_item<0>(kp->pool_w + (size_t)gi_ * 65536, 256, 256, Wpool_t + (size_t)gi_ * 65536, scr, r_ % I_POOL, lane); } \
        else if (r_ < IT_DN) { r_ -= IT_UP; const int l_ = r_ / I_UP; transpose_item_up(kp->w_up + (size_t)l_ * DM * NUP, Wup_t + (size_t)l_ * 2 * NUP * DM, kp->ffn_norm + l_ * DM, \
                modf + (size_t)(l_ * 3) * NMOD + 4 * DM, modf + (size_t)(l_ * 3 + 1) * NMOD + 4 * DM, scr, r_ % I_UP, lane); } \
        else { r_ -= IT_DN; const int l_ = r_ / I_DN; transpose_item<0>(kp->w_down + (size_t)l_ * DFF * DM, DFF, DM, Wdn_t + (size_t)l_ * DM * DFF, scr, r_ % I_DN, lane); } } while (0)
#define BIAS_UP_CHUNK(l_, chunk_) do { LAS float* vecs_ = (LAS float*)lds; LAS float* red_ = (LAS float*)(lds + 16384); const int col0_ = (chunk_) * 64; \
        { float tv_[4]; _Pragma("unroll") for (int q_ = 0; q_ < 4; ++q_) { const int i_ = tid + q_ * NTHREADS, v_ = i_ >> 10, k_ = i_ & 1023; tv_[q_] = modf[((l_) * 3 + v_) * NMOD + 3 * DM + k_]; } \
          asm volatile("" ::: "memory"); _Pragma("unroll") for (int q_ = 0; q_ < 4; ++q_) vecs_[tid + q_ * NTHREADS] = tv_[q_]; } \
        LDS_WAIT(); __syncthreads(); \
        const float r_ = gemv64<2>(kp->w_up + (size_t)(l_) * DM * NUP, NUP, col0_, vecs_, red_, tid); \
        if (tid < 128) bias_up[((l_) * 2 + (tid >> 6)) * NUP + map_up(col0_ + (tid & 63))] = r_; \
        __syncthreads(); } while (0)
    for (int pi = lo; pi < hi; ++pi) {
        const int pe = args.prog[pi], ph = pe & 255; const bool probe = (pe & 256) != 0; (void)probe;
        int tid = TID_NOW(); asm volatile("" : "+v"(tid));
        const KArgs* kp = (const KArgs*)__builtin_amdgcn_kernarg_segment_ptr(); asm volatile("" : "+s"(kp));
        unsigned char* ws = kp->ws;
#define LANE_VARS const int lane = tid & 63, wave = __builtin_amdgcn_readfirstlane(tid >> 6); const int gw = vcu * NWAVES + wave, NGW = G * NWAVES; (void)lane; (void)gw; (void)NGW;
        float* modf = (float*)(ws + WS_MODF);
        f32x2* tab = (f32x2*)(ws + WS_TAB);
        float* bias_in = (float*)(ws + WS_BIN);
        float* bias_up = (float*)(ws + WS_BUP);
        float* gperm = (float*)(ws + WS_GP);
        float* rstd0 = (float*)(ws + WS_RSTD0);
        float* halo = (float*)(ws + WS_HALO);
        bf16_t* Win_t = (bf16_t*)(ws + WS_WIN); bf16_t* Wout_t = (bf16_t*)(ws + WS_WOUT); bf16_t* Wpool_t = (bf16_t*)(ws + WS_WPOOL);
        bf16_t* Wup_t = (bf16_t*)(ws + WS_WUP); bf16_t* Wdn_t = (bf16_t*)(ws + WS_WDN);
        bf16_t* XB = (bf16_t*)(ws + WS_XB); bf16_t* Qb = (bf16_t*)(ws + WS_Q); bf16_t* KA = (bf16_t*)(ws + WS_KA); bf16_t* VA = (bf16_t*)(ws + WS_VA);
        bf16_t* BU = (bf16_t*)(ws + WS_BU); bf16_t* CC = (bf16_t*)(ws + WS_CC); bf16_t* Hb = (bf16_t*)(ws + WS_H); bf16_t* PL = (bf16_t*)(ws + WS_PL);
        if (PHM(0) && ph == PH_MOD) {
            LANE_VARS
            const int vs = (G == 256) ? ((vcu & 31) < 24 ? (vcu >> 5) * 24 + (vcu & 31) : 192 + (vcu >> 5) * 8 + ((vcu & 31) - 24)) : vcu;
            LAS float* vecs = (LAS float*)lds; LAS float* red = (LAS float*)(lds + 16384);
            { float tv[6];
#pragma unroll
              for (int q = 0; q < 6; ++q) { const int i = tid + q * NTHREADS, v = i >> 10, k = i & 1023; tv[q] = v < 2 ? kp->c[v * 1024 + k] : kp->c_ctx[k]; }
              asm volatile("" ::: "memory");
#pragma unroll
              for (int q = 0; q < 6; ++q) vecs[tid + q * NTHREADS] = silu_f(tv[q]); }
            LDS_WAIT(); __syncthreads();
            if (!(pe & 2048)) for (int chunk = vs; chunk < 2 * 96; chunk += G) { const int l = chunk / 96, col0 = (chunk % 96) * 64;
                const float r = gemv64<3>(kp->ada_w + (size_t)l * DM * NMOD, NMOD, col0, vecs, red, tid);
                if (tid < 192) modf[(l * 3 + (tid >> 6)) * NMOD + col0 + (tid & 63)] = r + kp->ada_b[l * NMOD + col0 + (tid & 63)]; }
            __syncthreads();
            const bool split0 = G > 192 + 32;
            if (!split0 || vs >= 192) {
                const int gwx = split0 ? (vs - 192) * NWAVES + wave : gw, ngwx = split0 ? (G - 192) * NWAVES : NGW;
                for (int i = gwx * 64 + lane; i < 192 * 32 + 256; i += ngwx * 64) {
                if (i < 192 * 32) { const int pos = (i >> 5) < 128 ? (i >> 5) : (i >> 5) - 128, f = i & 31;
                    const float inv = powf(10000.0f, -(float)(2 * f) / 64.0f); const float ang = (float)pos * inv;
                    tab[i] = (f32x2){cosf(ang), sinf(ang)};
                } else { const int j = i - 192 * 32, hq = j >> 7, dp = j & 127, p = dp >> 1, hf = dp & 1, a = p >> 5, fi = p & 31, d = a * 64 + hf * 32 + fi;
                    gperm[j] = hq == 0 ? kp->q_gain[d] : kp->k_gain[d]; }
                }
            }
            {
                constexpr int NITEM = MALL / 4;
                const int nlo = 192 * NWAVES, nhi_items = NITEM - 2 * nlo;
                int it0, itn, its;
                if (split0 && G == 256) { if (vs >= 192) { it0 = (vs - 192) * NWAVES + wave; itn = nhi_items; its = 64 * NWAVES; } else { it0 = nhi_items + vs * NWAVES + wave; itn = NITEM; its = nlo; } }
                else { it0 = gw; itn = NITEM; its = NGW; }
#define XP_LOAD(buf, item) do { const int r0_ = (item) * 4; const float* src_ = r0_ < MROWS ? kp->x + (size_t)r0_ * DM : kp->ctx + (size_t)(r0_ - MROWS) * DM; \
                    _Pragma("unroll") for (int q = 0; q < 4; ++q) _Pragma("unroll") for (int j = 0; j < 4; ++j) buf[q][j] = __builtin_nontemporal_load((const f32x4*)(src_ + (size_t)q * DM + 256 * j + 4 * lane)); } while (0)
#define XP_DONE(buf, item) do { const int r0_ = (item) * 4; float sq[4]; \
                    _Pragma("unroll") for (int q = 0; q < 4; ++q) { float s_ = 0.f; \
                        _Pragma("unroll") for (int j = 0; j < 4; ++j) s_ += (buf[q][j][0] * buf[q][j][0] + buf[q][j][1] * buf[q][j][1]) + (buf[q][j][2] * buf[q][j][2] + buf[q][j][3] * buf[q][j][3]); \
                        sq[q] = wave_sum(s_); } \
                    if (lane < 4) rstd0[r0_ + lane] = __builtin_amdgcn_rsqf((lane == 0 ? sq[0] : lane == 1 ? sq[1] : lane == 2 ? sq[2] : sq[3]) * (1.0f / DM) + EPS); \
                    _Pragma("unroll") for (int q = 0; q < 4; ++q) _Pragma("unroll") for (int j = 0; j < 4; ++j) { const int c = 256 * j + 4 * lane; const f32x4 z = buf[q][j]; \
                        u32x2 w; w.x = cvtpk(z[0], z[1]); w.y = cvtpk(z[2], z[3]); *(u32x2*)(XB + (size_t)(r0_ + q) * DM + c) = w; } } while (0)
                if (!(pe & 1024)) for (int r4 = it0; r4 < itn; r4 += 2 * its) {
                    f32x4 xa[4][4], xb2[4][4];
                    const bool hasb = r4 + its < itn; const int r4b = hasb ? r4 + its : r4;
                    XP_LOAD(xa, r4);
                    XP_LOAD(xb2, r4b);
                    asm volatile("" ::: "memory");
                    XP_DONE(xa, r4);
                    if (hasb) XP_DONE(xb2, r4b);
                }
#undef XP_LOAD
#undef XP_DONE
            }
        } else if (PHM(1) && ph == PH_PREP) {
            LANE_VARS
            const int vp = (G == 256) ? ((vcu & 31) < 5 ? (vcu >> 5) * 5 + (vcu & 31) : 40 + (vcu >> 5) * 27 + ((vcu & 31) - 5)) : vcu;
            {
                LAS float* vecs = (LAS float*)lds; LAS float* red = (LAS float*)(lds + 16384);
                for (int chunk = vp; chunk < 40; chunk += G) {
                    __syncthreads();
                    { float tv[6];
#pragma unroll
                      for (int q = 0; q < 6; ++q) { const int i = tid + q * NTHREADS, v = i >> 10, k = i & 1023; tv[q] = modf[(0 * 3 + v) * NMOD + k]; }
                      asm volatile("" ::: "memory");
#pragma unroll
                      for (int q = 0; q < 6; ++q) vecs[tid + q * NTHREADS] = tv[q]; }
                    LDS_WAIT(); __syncthreads();
                    const int col0 = chunk * 64;
                    const float r = gemv64<3>(kp->w_in, NIN, col0, vecs, red, tid);
                    if (tid < 192) bias_in[(tid >> 6) * NIN + map_in(col0 + (tid & 63))] = r;
                }
                __syncthreads();
            }
            const bool split1 = G > 40 + 64;
            const int gwy = split1 ? (vp - 40) * NWAVES + wave : gw, ngwy = split1 ? (G - 40) * NWAVES : NGW;
            if (!split1 || vp >= 40) {
                LAS float* scr = (LAS float*)(lds + wave * 16384);
                for (int it = gwy; it < I_IN; it += ngwy) { TRANSPOSE_IT(it); }
            }
        } else if (PHM(2) && ph == PH_INPROJ) {
            pg8::Gemm g{XB, DM, 0, Win_t, DM, DM, (size_t)NIN * DM * 2};
            pg8::InProjOrder S; S.init(G, bid);
            pg8::EpiInProj E{ws};
            pg8::gemm_phase(lds, xlds, g, S, E, tid);
            if (G == 256 && bid >= 132) {
                LANE_VARS
                const int share = bid - 132, nshare = 124;
                if (share < 88) BIAS_UP_CHUNK(0, share);
                LAS float* scr = (LAS float*)(lds + wave * 16384);
                for (int j = share * NWAVES + wave; j < I_OUT + I_UP; j += nshare * NWAVES) { const int it = j < I_OUT ? IT_OUT + j : IT_UP + (j - I_OUT); TRANSPOSE_IT(it); }
            } else if (G != 256) {
                LANE_VARS
                for (int ch = vcu; ch < 88; ch += G) BIAS_UP_CHUNK(0, ch);
                LAS float* scr = (LAS float*)(lds + wave * 16384);
                for (int j = gw; j < I_OUT + I_UP; j += NGW) { const int it = j < I_OUT ? IT_OUT + j : IT_UP + (j - I_OUT); TRANSPOSE_IT(it); }
            }
        } else if (PHM(3) && ph == PH_ATTN) {
            LANE_VARS
            for (int r8 = gw; r8 < MROWS / 8; r8 += NGW) {
                const int r0 = r8 * 8, c = lane * 8;
                f32x4 k0a = *(const f32x4*)(kp->conv_w + c), k0b = *(const f32x4*)(kp->conv_w + c + 4);
                f32x4 k1a = *(const f32x4*)(kp->conv_w + 512 + c), k1b = *(const f32x4*)(kp->conv_w + 512 + c + 4);
                f32x4 k2a = *(const f32x4*)(kp->conv_w + 1024 + c), k2b = *(const f32x4*)(kp->conv_w + 1024 + c + 4);
                const float kw0[8] = {k0a[0], k0a[1], k0a[2], k0a[3], k0b[0], k0b[1], k0b[2], k0b[3]};
                const float kw1[8] = {k1a[0], k1a[1], k1a[2], k1a[3], k1b[0], k1b[1], k1b[2], k1b[3]};
                const float kw2[8] = {k2a[0], k2a[1], k2a[2], k2a[3], k2b[0], k2b[1], k2b[2], k2b[3]};
                u32x4 uu[10], bbv[8];
#pragma unroll
                for (int i = 0; i < 10; ++i) { const int r = r0 - 1 + i;
                    const bool inb = (i == 0) ? ((r0 & (SEQ - 1)) != 0) : ((i == 9) ? (((r0 + 8) & (SEQ - 1)) != 0) : true);
                    const int rc = inb ? r : r0;
                    const u32x4 ld = __builtin_nontemporal_load((const u32x4*)(BU + (size_t)rc * DM + 512 + c));
                    uu[i] = inb ? ld : (u32x4){0u, 0u, 0u, 0u}; }
#pragma unroll
                for (int i = 0; i < 8; ++i) bbv[i] = __builtin_nontemporal_load((const u32x4*)(BU + (size_t)(r0 + i) * DM + c));
#pragma unroll
                for (int i = 0; i < 8; ++i) { const u32x4 up = uu[i], cu = uu[i + 1], dn = uu[i + 2], bb = bbv[i];
                    u32x4 o;
#pragma unroll
                    for (int q = 0; q < 4; ++q) {
                        const float y0 = bflo(bb[q]) * (kw0[2 * q] * bflo(up[q]) + kw1[2 * q] * bflo(cu[q]) + kw2[2 * q] * bflo(dn[q]));
                        const float y1 = bfhi(bb[q]) * (kw0[2 * q + 1] * bfhi(up[q]) + kw1[2 * q + 1] * bfhi(cu[q]) + kw2[2 * q + 1] * bfhi(dn[q]));
                        o[q] = cvtpk(y0, y1); }
                    *(u32x4*)(CC + (size_t)(r0 + i) * DM + 512 + c) = o; }
            }
            __syncthreads();
            for (int unit = vcu; unit < 256; unit += G) {
                const int combo = unit >> 6, within = unit & 63, b = combo >> 1, kvh = combo & 1, h = kvh * 2 + (within >> 5), qb = within & 31;
                const size_t qrow = (size_t)b * SEQ + qb * 256;
                attn::attn_dense_body((const attn::bf16*)Qb + qrow * 512 + h * 128, (const attn::bf16*)KA + (size_t)b * SKV * 256 + kvh * 128,
                                      (const attn::bf16*)VA + (size_t)b * SKV * 256 + kvh * 128, (attn::bf16*)CC + qrow * DM + h * 128, SKV, (char*)lds_raw, lds, tid);
                __syncthreads();
            }
        } else if (PHM(4) && (ph == PH_OUTPROJ || ph == PH_DOWN0 || ph == PH_POOLG || ph == PH_DOWN1)) {
            const int k = ph == PH_OUTPROJ ? 0 : (ph == PH_DOWN0 ? 1 : (ph == PH_POOLG ? 2 : 3));
            const size_t a_off = k == 0 ? WS_CC : (k == 2 ? WS_PL : WS_H);
            const size_t b_off = k == 0 ? WS_WOUT : (k == 1 ? WS_WDN : (k == 2 ? WS_WPOOL : WS_WDN + (size_t)DM * DFF * 2));
            const int lda = (k == 0 || k == 2) ? DM : DFF, ldb = k == 0 ? DM : (k == 2 ? 256 : DFF), acol = k == 2 ? 256 : 0;
            pg8::Gemm g{(const bf16_t*)(ws + a_off), lda, acol, (const bf16_t*)(ws + b_off), ldb, ldb, 0};
            pg8::EpiResid E{ws, kp, k, probe ? 1 : 0};
            pg8::StaticOrder S; S.init(MROWS, DM, G, bid);
            { pg8::Unit u0; if (S.next(0, u0)) {
                const int pm = u0.pm;
                if (k == 1 || k == 3) {
                    const float* cw = kp->fconv_w + (size_t)(k == 3 ? 1 : 0) * 3 * DFF;
                    constexpr int NIT = (DFF + NTHREADS - 1) / NTHREADS;
                    f32x2 P[NIT], val[NIT], nb[NIT], wv[NIT];
#pragma unroll
                    for (int q = 0; q < NIT; ++q) { const int i_ = tid + q * NTHREADS, i = i_ < DFF ? i_ : DFF - 1;
                        const int edge = i >= DFF / 2 ? 1 : 0, ch = 2 * (i - edge * (DFF / 2)), pn_ = ch >> 7, cc = ch & 127;
                        const float* hp = halo + ((size_t)(pm * 22 + pn_) * 6 + edge * 3) * 128 + cc;
                        P[q] = *(const f32x2*)hp; val[q] = *(const f32x2*)(hp + 128);
                        const bool nbv = edge == 0 ? ((pm & 31) != 0) : ((pm & 31) != 31);
                        const int pmn = nbv ? (edge == 0 ? pm - 1 : pm + 1) : pm;
                        const f32x2 nbl = *(const f32x2*)(halo + ((size_t)(pmn * 22 + pn_) * 6 + (edge == 0 ? 5 : 2)) * 128 + cc);
                        nb[q] = nbv ? nbl : (f32x2){0.f, 0.f};
                        wv[q] = *(const f32x2*)(cw + (edge == 0 ? 0 : 2) * DFF + ch); }
#pragma unroll
                    for (int q = 0; q < NIT; ++q) { const int i = tid + q * NTHREADS;
                        if (i < DFF) { const int edge = i >= DFF / 2 ? 1 : 0, ch = 2 * (i - edge * (DFF / 2));
                            const float h0 = silu_f(P[q].x + wv[q].x * nb[q].x) * val[q].x, h1 = silu_f(P[q].y + wv[q].y * nb[q].y) * val[q].y;
                            *(unsigned*)(Hb + ((size_t)pm * 256 + (edge ? 255 : 0)) * DFF + ch) = cvtpk(h0, h1); } }
                } else if (k == 2) {
                    LANE_VARS
                    const bf16_t* xr = (const bf16_t*)(ws + WS_XB); const float* ssq = (const float*)(ws + WS_SSQ + SSQ_BYTES);
                    const int b = pm >> 5, gi = u0.pn, t0 = (pm & 31) * 256 + wave * 32, c = gi * 256 + lane * 4;
                    const f32x4 nv = *(const f32x4*)(kp->mix_norm + DM + c) * (1.0f + *(const f32x4*)(modf + (3 + b) * NMOD + DM + c));
                    float rs_l = 0.f;
                    { const int t = t0 - 8 + lane; if (lane < 48 && t >= 0 && t < SEQ) { const f32x4* sp = (const f32x4*)(ssq + ((size_t)b * SEQ + t) * 16); const f32x4 s0 = sp[0], s1 = sp[1], s2 = sp[2], s3 = sp[3];
                        const float tot = ((s0[0] + s0[1]) + (s0[2] + s0[3])) + ((s1[0] + s1[1]) + (s1[2] + s1[3])) + ((s2[0] + s2[1]) + (s2[2] + s2[3])) + ((s3[0] + s3[1]) + (s3[2] + s3[3]));
                        rs_l = __builtin_amdgcn_rsqf(tot * (1.0f / DM) + EPS); } }
                    const bf16_t* xb = xr + (size_t)b * SEQ * DM + c;
                    const int tile0 = (pm & 31) * 256;
                    const int pmp = tile0 > 0 ? pm - 1 : pm, pmn = tile0 < SEQ - 256 ? pm + 1 : pm;
                    const bf16_t* xe_prev = (const bf16_t*)(ws + WS_XE) + (size_t)(pmp * 4 + gi) * 16 * 256 + lane * 4;
                    const bf16_t* xe_next = (const bf16_t*)(ws + WS_XE) + (size_t)(pmn * 4 + gi) * 16 * 256 + lane * 4;
                    bf16_t* dst = PL + (size_t)b * SEQ * DM + c;
                    if (gi == 0) pool_rows32<1>(xb, xe_prev, xe_next, tile0, t0, rs_l, nv, dst);
                    else if (gi == 1) pool_rows32<2>(xb, xe_prev, xe_next, tile0, t0, rs_l, nv, dst);
                    else if (gi == 2) pool_rows32<4>(xb, xe_prev, xe_next, tile0, t0, rs_l, nv, dst);
                    else pool_rows32<8>(xb, xe_prev, xe_next, tile0, t0, rs_l, nv, dst);
                }
                VM_WAIT(); __syncthreads();
            } }
            pg8::gemm_phase(lds, xlds, g, S, E, tid);
        } else if (PHM(5) && (ph == PH_UP0 || ph == PH_UP1)) {
            const int l = ph == PH_UP0 ? 0 : 1;
            pg8::Gemm g{(const bf16_t*)(ws + WS_XB), DM, 0, Wup_t + (size_t)l * 2 * NUP * DM, DM, DM, (size_t)NUP * DM * 2};
            pg8::EpiFfnUp E{ws, kp, l, (pe & 512) ? 1 : 0};
            pg8::StaticOrder S; S.init(MROWS, NUP, G, bid);
            if (tid == 0) *(volatile LAS int*)(xlds + 4096 + 1024) = -1;
            LDS_WAIT(); __syncthreads();
#if defined(PROBE_PHASE)
            pg8::gemm_phase(lds, xlds, g, S, E, tid, (pe >> 12) & 3);
#else
            pg8::gemm_phase(lds, xlds, g, S, E, tid);
#endif
            if (l == 0) {
                const bool std_grid = (G == 256);
                if (!std_grid || bid >= 128) {
                    LANE_VARS
                    const int share = std_grid ? bid - 128 : vcu, nshare = std_grid ? 128 : G;
                    for (int ch = share; ch < 88; ch += nshare) BIAS_UP_CHUNK(1, ch);
                    LAS float* scr = (LAS float*)(lds + wave * 16384);
                    constexpr int NJ = 4 * I_POOL + I_UP + I_DN;
                    for (int j = share * NWAVES + wave; j < NJ; j += nshare * NWAVES) {
                        const int it = j < 4 * I_POOL ? IT_POOL + j : (j < 4 * I_POOL + I_UP ? IT_UP + I_UP + (j - 4 * I_POOL) : IT_DN + (j - 4 * I_POOL - I_UP));
                        TRANSPOSE_IT(it); }
                }
            } else {
                const bool std_grid = (G == 256);
                if (!std_grid || bid >= 128) {
                    LANE_VARS
                    const int share = std_grid ? bid - 128 : vcu, nshare = std_grid ? 128 : G;
                    LAS float* scr = (LAS float*)(lds + wave * 16384);
                    for (int j = share * NWAVES + wave; j < I_DN; j += nshare * NWAVES) { const int it = IT_DN + I_DN + j; TRANSPOSE_IT(it); }
                }
            }
        }
        if (use_bar && pi + 1 < hi) xcd_barrier(bar, TID_NOW() == 0);
    }
}


extern "C" void kernel_launch(void* const* d_in, const int* in_sizes, int n_in, void* d_out, int out_size, void* d_ws, size_t ws_size, hipStream_t stream) {
    static int grid = 0;
    if (grid == 0) {
        if (n_in != 19 || in_sizes[0] != MROWS * DM || out_size != MROWS * DM || ws_size < WS_TOP) {
            fprintf(stderr, "kernel_launch: unexpected shapes: n_in %d in0 %d out %d ws %zu (need %zu)\n", n_in, n_in > 0 ? in_sizes[0] : -1, out_size, ws_size, (size_t)WS_TOP); grid = -1; return; }
        int dev = 0, cus = 0;
        if (hipGetDevice(&dev) != hipSuccess || hipDeviceGetAttribute(&cus, hipDeviceAttributeMultiprocessorCount, dev) != hipSuccess) { grid = -1; return; }
        int per_cu = 0;
        if (hipOccupancyMaxActiveBlocksPerMultiprocessor(&per_cu, (const void*)fwd_kernel, NTHREADS, 0) != hipSuccess || per_cu < 1) fprintf(stderr, "kernel_launch: occupancy query says %d\n", per_cu);
        (void)hipGetLastError();
        grid = cus;
    }
    if (grid < 0) return;
    (void)hipMemsetAsync((char*)d_ws + WS_CTL + 4096 * 4, 0, XCD_BAR_WORDS * 4, stream);
    Args a{};
    const float** ap = (const float**)&a;
    for (int i = 0; i < 19; ++i) ap[i] = (const float*)d_in[i];
    a.out = (float*)d_out; a.ws = (unsigned char*)d_ws; a.grid = grid;
    constexpr int NL = MK_N_LAUNCHES;
    int np = 0;
    for (int p = 0; p < (int)PH_COUNT; ++p) {
#if defined(PROBE_PHASE)
        if (p == PROBE_PHASE) a.prog[np++] = p | 256 | PROBE_FLAGS;
#endif
        a.prog[np++] = p;
    }
    for (int li = 0; li < NL; ++li) {
        a.ph_lo = (NL == 1) ? 0 : li; a.ph_hi = (NL == 1) ? np : li + 1;
        hipLaunchKernelGGL(fwd_kernel, dim3(grid), dim3(NTHREADS), 0, stream, a);
        const hipError_t le = hipPeekAtLastError();
        if (le != hipSuccess) { fprintf(stderr, "kernel_launch: launch %d failed: %s\n", li, hipGetErrorName(le)); break; }
    }
}
```
